# Optimizing an MI355X kernel written in HIP

```python
import jax, jax.numpy as jnp
from jax import lax
import numpy as np

D_MODEL = 1024
BATCH = 2
SEQ = 8192
DEPTH = 4

HEAD_DIM = 64
NSA_HEADS = 8
NSA_KV_GROUPS = 2
NSA_HPG = NSA_HEADS // NSA_KV_GROUPS
MOBA_HEADS = 8
CMP_STRIDE = 16
CMP_LEN = 2 * CMP_STRIDE
CMP_HIDDEN = 128
SEL_BLOCK = 64
SEL_TOPK = 16
WINDOW = 512
MOBA_BLOCK = 256
MOBA_TOPK = 3
Q_CHUNK = 128
ROPE_THETA = 10000.0
D_FF = -(-8 * D_MODEL // (3 * 256)) * 256
NEG = -1e30
FORCE_SCORE = 1e4

NSA_QW = NSA_HEADS * HEAD_DIM
NSA_KVW = NSA_KV_GROUPS * HEAD_DIM
NSA_GATEW = NSA_HEADS * 3
MOBA_W = MOBA_HEADS * HEAD_DIM
BRANCH_GATEW = 2 * D_MODEL
IN_SPLITS = (NSA_QW, NSA_KVW, NSA_KVW, NSA_KVW, NSA_KVW, NSA_KVW, NSA_KVW, NSA_GATEW, MOBA_W, MOBA_W, MOBA_W, BRANCH_GATEW)
IN_COLS = NSA_QW + 6 * NSA_KVW + NSA_GATEW + 3 * MOBA_W + BRANCH_GATEW

kernel_name = "nsa_moba_gated_hybrid_trunk"


def rms_norm(x, g, eps=1e-6):
    x32 = x.astype(jnp.float32)
    y = x32 * lax.rsqrt(jnp.mean(x32 * x32, axis=-1, keepdims=True) + eps)
    return y.astype(x.dtype) * g


def rope_angles(pos):
    inv = 1.0 / (ROPE_THETA ** (jnp.arange(0, HEAD_DIM, 2, dtype=jnp.float32) / HEAD_DIM))
    ang = pos.astype(jnp.float32)[..., None] * inv
    return jnp.cos(ang), jnp.sin(ang)


def apply_rope(x, cos, sin):
    cos = cos.astype(x.dtype)
    sin = sin.astype(x.dtype)
    x1, x2 = jnp.split(x, 2, axis=-1)
    return jnp.concatenate([x1 * cos - x2 * sin, x2 * cos + x1 * sin], axis=-1)


def masked_softmax(s, mask):
    s = jnp.where(mask, s.astype(jnp.float32), NEG)
    return jnp.where(mask, jax.nn.softmax(s, axis=-1), 0.0)


def _heads(t, n):
    b, s, _ = t.shape
    return t.reshape(b, s, n, HEAD_DIM).transpose(0, 2, 1, 3)


def nsa_mixer(q, k_cmp, v_cmp, k_slc, v_slc, k_win, v_win, gate_logits, positions, cos, sin,
              q_gain, k_gain, cmp_pe, ck_w1, ck_w2, cv_w1, cv_w2):
    B, S, _ = q.shape
    G, HPG, DH = NSA_KV_GROUPS, NSA_HPG, HEAD_DIM
    scale = DH ** -0.5
    cs, sn = cos[:, None], sin[:, None]
    q = apply_rope(rms_norm(_heads(q, NSA_HEADS), q_gain), cs, sn).reshape(B, G, HPG, S, DH)
    k_slc = apply_rope(rms_norm(_heads(k_slc, G), k_gain), cs, sn)
    k_win = apply_rope(rms_norm(_heads(k_win, G), k_gain), cs, sn)
    v_slc = _heads(v_slc, G)
    v_win = _heads(v_win, G)

    n_cmp = S // CMP_STRIDE - 1

    def blocks(t):
        tc = t.reshape(B, G, S // CMP_STRIDE, CMP_STRIDE, DH)
        blk = jnp.concatenate([tc[:, :, :-1], tc[:, :, 1:]], axis=3) + cmp_pe
        return blk.reshape(B, G, n_cmp, CMP_LEN * DH)

    k_c = jax.nn.gelu(blocks(_heads(k_cmp, G)) @ ck_w1) @ ck_w2
    v_c = jax.nn.gelu(blocks(_heads(v_cmp, G)) @ cv_w1) @ cv_w2
    cmp_start = jnp.arange(n_cmp) * CMP_STRIDE
    cmp_end = cmp_start + CMP_LEN - 1
    cos_c, sin_c = rope_angles(positions[:, cmp_end])
    k_c = apply_rope(rms_norm(k_c, k_gain), cos_c[:, None], sin_c[:, None])

    n_sb = S // SEL_BLOCK
    n_pick = min(SEL_TOPK, n_sb)
    sel_start = jnp.arange(n_sb) * SEL_BLOCK
    overlap = ((cmp_start[:, None] < sel_start[None, :] + SEL_BLOCK) &
               (cmp_start[:, None] + CMP_LEN > sel_start[None, :])).astype(jnp.float32)
    k_sb = k_slc.reshape(B, G, n_sb, SEL_BLOCK, DH)
    v_sb = v_slc.reshape(B, G, n_sb, SEL_BLOCK, DH)
    k_wp = jnp.pad(k_win, ((0, 0), (0, 0), (WINDOW, 0), (0, 0)))
    v_wp = jnp.pad(v_win, ((0, 0), (0, 0), (WINDOW, 0), (0, 0)))
    gates = jax.nn.sigmoid(gate_logits).reshape(B, S, G, HPG, 3).transpose(0, 2, 3, 1, 4)
    bi = jnp.arange(B)[:, None, None, None]
    gi = jnp.arange(G)[None, :, None, None]
    blk_id = jnp.arange(n_sb)

    def chunk(ci):
        s0 = ci * Q_CHUNK
        t = s0 + jnp.arange(Q_CHUNK)
        qc = lax.dynamic_slice_in_dim(q, s0, Q_CHUNK, axis=3)
        s_c = jnp.einsum('bghqd,bgnd->bghqn', qc, k_c) * scale
        p_c = masked_softmax(s_c, cmp_end[None, :] <= t[:, None])
        o_c = jnp.einsum('bghqn,bgnd->bghqd', p_c.astype(v_c.dtype), v_c)
        imp = jnp.einsum('bghqn,nj->bgqj', p_c, overlap)
        forced = (blk_id[None, :] == 0) | (blk_id[None, :] == (t // SEL_BLOCK)[:, None])
        imp = jnp.where(forced, FORCE_SCORE, imp)
        imp = jnp.where(sel_start[None, :] <= t[:, None], imp, NEG)
        _, idx = lax.top_k(imp, n_pick)
        kg = k_sb[bi, gi, idx]
        vg = v_sb[bi, gi, idx].reshape(B, G, Q_CHUNK, n_pick * SEL_BLOCK, DH)
        tok = idx[..., None] * SEL_BLOCK + jnp.arange(SEL_BLOCK)
        m_s = (tok <= t[:, None, None]).reshape(B, G, 1, Q_CHUNK, n_pick * SEL_BLOCK)
        s_s = jnp.einsum('bghqd,bgqnkd->bghqnk', qc, kg).reshape(B, G, HPG, Q_CHUNK, n_pick * SEL_BLOCK) * scale
        p_s = masked_softmax(s_s, m_s)
        o_s = jnp.einsum('bghqm,bgqmd->bghqd', p_s.astype(vg.dtype), vg)
        kw = lax.dynamic_slice_in_dim(k_wp, s0, Q_CHUNK + WINDOW, axis=2)
        vw = lax.dynamic_slice_in_dim(v_wp, s0, Q_CHUNK + WINDOW, axis=2)
        kpos = s0 - WINDOW + jnp.arange(Q_CHUNK + WINDOW)
        m_w = (kpos[None, :] <= t[:, None]) & (kpos[None, :] > t[:, None] - WINDOW) & (kpos[None, :] >= 0)
        s_w = jnp.einsum('bghqd,bgkd->bghqk', qc, kw) * scale
        p_w = masked_softmax(s_w, m_w)
        o_w = jnp.einsum('bghqk,bgkd->bghqd', p_w.astype(vw.dtype), vw)
        gc = lax.dynamic_slice_in_dim(gates, s0, Q_CHUNK, axis=3)
        return gc[..., 0:1] * o_c + gc[..., 1:2] * o_s + gc[..., 2:3] * o_w

    out = lax.map(chunk, jnp.arange(S // Q_CHUNK))
    return out.transpose(1, 0, 4, 2, 3, 5).reshape(B, S, NSA_HEADS * DH)


def moba_mixer(q, k, v, cos, sin, q_gain, k_gain):
    B, S, _ = q.shape
    H, DH, MB = MOBA_HEADS, HEAD_DIM, MOBA_BLOCK
    scale = DH ** -0.5
    cs, sn = cos[:, None], sin[:, None]
    q = apply_rope(rms_norm(_heads(q, H), q_gain), cs, sn)
    k = apply_rope(rms_norm(_heads(k, H), k_gain), cs, sn)
    v = _heads(v, H)
    n_blk = -(-S // MB)
    pad = n_blk * MB - S
    k_p = jnp.pad(k, ((0, 0), (0, 0), (0, pad), (0, 0)))
    v_p = jnp.pad(v, ((0, 0), (0, 0), (0, pad), (0, 0)))
    k_blk = k_p.reshape(B, H, n_blk, MB, DH)
    v_blk = v_p.reshape(B, H, n_blk, MB, DH)
    k_mean = jnp.mean(k_blk.astype(jnp.float32), axis=3).astype(k.dtype)
    n_pick = min(MOBA_TOPK, n_blk)
    bi = jnp.arange(B)[:, None, None, None]
    hi = jnp.arange(H)[None, :, None, None]
    blk_id = jnp.arange(n_blk)

    def chunk(ci):
        s0 = ci * Q_CHUNK
        t = s0 + jnp.arange(Q_CHUNK)
        own = s0 // MB
        qc = lax.dynamic_slice_in_dim(q, s0, Q_CHUNK, axis=2)
        gate = jnp.einsum('bhqd,bhnd->bhqn', qc, k_mean).astype(jnp.float32)
        _, idx = lax.top_k(jnp.where(blk_id < own, gate, NEG), n_pick)
        m_sel = jnp.repeat(idx < own, MB, axis=-1)
        kg = k_blk[bi, hi, idx]
        vg = v_blk[bi, hi, idx].reshape(B, H, Q_CHUNK, n_pick * MB, DH)
        s_sel = jnp.einsum('bhqd,bhqnkd->bhqnk', qc, kg).reshape(B, H, Q_CHUNK, n_pick * MB) * scale
        ko = lax.dynamic_slice_in_dim(k_p, own * MB, MB, axis=2)
        vo = lax.dynamic_slice_in_dim(v_p, own * MB, MB, axis=2)
        s_own = jnp.einsum('bhqd,bhkd->bhqk', qc, ko) * scale
        m_own = jnp.broadcast_to((own * MB + jnp.arange(MB))[None, :] <= t[:, None], s_own.shape)
        p = masked_softmax(jnp.concatenate([s_sel, s_own], axis=-1),
                           jnp.concatenate([m_sel, m_own], axis=-1)).astype(v.dtype)
        return (jnp.einsum('bhqm,bhqmd->bhqd', p[..., :n_pick * MB], vg) +
                jnp.einsum('bhqk,bhkd->bhqd', p[..., n_pick * MB:], vo))

    out = lax.map(chunk, jnp.arange(S // Q_CHUNK))
    return out.transpose(1, 0, 3, 2, 4).reshape(B, S, H * DH)


def setup_inputs(seed: int = 0) -> dict:
    key = jax.random.key(seed)
    ks = jax.random.split(key, 24)

    def nrm(k, shape, s):
        return jax.random.normal(k, shape, jnp.float32) * s

    L, D, DH = DEPTH, D_MODEL, HEAD_DIM
    positions = (jnp.arange(SEQ, dtype=jnp.int32)[None, :] +
                 jax.random.randint(ks[2], (BATCH, 1), 0, 1024, dtype=jnp.int32)).astype(jnp.int32)
    return {
        "x": nrm(ks[0], (BATCH, SEQ, D), 1.0),
        "c": nrm(ks[1], (BATCH, D), 1.0),
        "positions": positions,
        "w_ada": nrm(ks[3], (L, D, 6 * D), 0.5 * D ** -0.5),
        "b_ada": nrm(ks[4], (L, 6 * D), 0.02),
        "norm_mix": 1.0 + nrm(ks[5], (L, D), 0.02),
        "norm_ffn": 1.0 + nrm(ks[6], (L, D), 0.02),
        "w_in": nrm(ks[7], (L, D, IN_COLS), D ** -0.5),
        "nsa_q_gain": 1.0 + nrm(ks[8], (L, DH), 0.02),
        "nsa_k_gain": 1.0 + nrm(ks[9], (L, DH), 0.02),
        "nsa_cmp_pe": nrm(ks[10], (L, CMP_LEN, DH), 0.1),
        "nsa_cmp_k_w1": nrm(ks[11], (L, CMP_LEN * DH, CMP_HIDDEN), (CMP_LEN * DH) ** -0.5),
        "nsa_cmp_k_w2": nrm(ks[12], (L, CMP_HIDDEN, DH), CMP_HIDDEN ** -0.5),
        "nsa_cmp_v_w1": nrm(ks[13], (L, CMP_LEN * DH, CMP_HIDDEN), (CMP_LEN * DH) ** -0.5),
        "nsa_cmp_v_w2": nrm(ks[14], (L, CMP_HIDDEN, DH), CMP_HIDDEN ** -0.5),
        "moba_q_gain": 1.0 + nrm(ks[15], (L, DH), 0.02),
        "moba_k_gain": 1.0 + nrm(ks[16], (L, DH), 0.02),
        "w_up_nsa": nrm(ks[17], (L, NSA_QW, D), NSA_QW ** -0.5),
        "w_up_moba": nrm(ks[18], (L, MOBA_W, D), MOBA_W ** -0.5),
        "w_out": nrm(ks[19], (L, D, D), D ** -0.5),
        "w_ffn_in": nrm(ks[20], (L, D, 2 * D_FF), D ** -0.5),
        "w_ffn_out": nrm(ks[21], (L, D_FF, D), D_FF ** -0.5),
    }


def reference(x, c, positions, w_ada, b_ada, norm_mix, norm_ffn, w_in,
              nsa_q_gain, nsa_k_gain, nsa_cmp_pe, nsa_cmp_k_w1, nsa_cmp_k_w2,
              nsa_cmp_v_w1, nsa_cmp_v_w2, moba_q_gain, moba_k_gain,
              w_up_nsa, w_up_moba, w_out, w_ffn_in, w_ffn_out):
    cos, sin = rope_angles(positions)
    split_at = np.cumsum(IN_SPLITS)[:-1].tolist()
    for l in range(DEPTH):
        ada = jax.nn.silu(c) @ w_ada[l] + b_ada[l]
        sh_m, sc_m, g_m, sh_f, sc_f, g_f = jnp.split(ada[:, None, :], 6, axis=-1)
        h = rms_norm(x, norm_mix[l]) * (1.0 + sc_m) + sh_m
        (q_a, kc_a, vc_a, ks_a, vs_a, kw_a, vw_a, g_a,
         q_b, k_b, v_b, g_br) = jnp.split(h @ w_in[l], split_at, axis=-1)
        y_a = nsa_mixer(q_a, kc_a, vc_a, ks_a, vs_a, kw_a, vw_a, g_a, positions, cos, sin,
                        nsa_q_gain[l], nsa_k_gain[l], nsa_cmp_pe[l], nsa_cmp_k_w1[l],
                        nsa_cmp_k_w2[l], nsa_cmp_v_w1[l], nsa_cmp_v_w2[l])
        y_b = moba_mixer(q_b, k_b, v_b, cos, sin, moba_q_gain[l], moba_k_gain[l])
        gate_a, gate_b = jnp.split(jax.nn.sigmoid(g_br), 2, axis=-1)
        merged = gate_a * (y_a @ w_up_nsa[l]) + gate_b * (y_b @ w_up_moba[l])
        x = x + g_m * (merged @ w_out[l])
        h = rms_norm(x, norm_ffn[l]) * (1.0 + sc_f) + sh_f
        gt, up = jnp.split(h @ w_ffn_in[l], 2, axis=-1)
        x = x + g_f * ((jax.nn.silu(gt) * up) @ w_ffn_out[l])
    return x
```

```cpp
#include <hip/hip_runtime.h>
#include <hip/hip_cooperative_groups.h>
#include <cstdio>
#include <cstdint>
namespace cg = cooperative_groups;

typedef unsigned short bf16_t;
typedef short bf16x8 __attribute__((ext_vector_type(8)));
typedef float f32x16 __attribute__((ext_vector_type(16)));
typedef float f32x2 __attribute__((ext_vector_type(2)));
typedef __bf16 bf2_t __attribute__((ext_vector_type(2)));
typedef unsigned u32x4 __attribute__((ext_vector_type(4)));
#define DI __device__ __forceinline__
#define MFMA32(a, b, c) __builtin_amdgcn_mfma_f32_32x32x16_bf16((a), (b), (c), 0, 0, 0)

constexpr int NB = 2, S = 8192, D = 1024, NL = 4, T = NB * S;
constexpr int NIN = 4888, NPIN = 4992, DFF = 2816, NFFI = 5632;
constexpr float L2E = 1.4426950408889634f;
constexpr float NEGF = -1e30f;

constexpr size_t O_WIN = 0;
constexpr size_t O_WUPA = O_WIN + (size_t)NPIN * 1024 * 2;
constexpr size_t O_WUPB = O_WUPA + (size_t)1024 * 512 * 2;
constexpr size_t O_WOUT = O_WUPB + (size_t)1024 * 512 * 2;
constexpr size_t O_WFFI = O_WOUT + (size_t)1024 * 1024 * 2;
constexpr size_t O_WFFO = O_WFFI + (size_t)NFFI * 1024 * 2;
constexpr size_t O_CKW1 = O_WFFO + (size_t)1024 * DFF * 2;
constexpr size_t O_CVW1 = O_CKW1 + (size_t)128 * 2048 * 2;
constexpr size_t O_CKW2 = O_CVW1 + (size_t)128 * 2048 * 2;
constexpr size_t O_CVW2 = O_CKW2 + (size_t)64 * 128 * 2;
constexpr size_t O_ADA = O_CVW2 + (size_t)64 * 128 * 2;
constexpr size_t O_COS = O_ADA + (size_t)NL * NB * 6144 * 4;
constexpr size_t O_SIN = O_COS + (size_t)T * 32 * 4;
constexpr size_t O_X = O_SIN + (size_t)T * 32 * 4;
constexpr size_t O_H = O_X + (size_t)T * 1024 * 4;
constexpr size_t O_QA = O_H + (size_t)T * 1024 * 2;
constexpr size_t O_KC = O_QA + (size_t)T * 512 * 2;
constexpr size_t O_VC = O_KC + (size_t)T * 128 * 2;
constexpr size_t O_KS = O_VC + (size_t)T * 128 * 2;
constexpr size_t O_KW = O_KS + (size_t)T * 128 * 2;
constexpr size_t O_VST = O_KW + (size_t)T * 128 * 2;
constexpr size_t O_VWT = O_VST + (size_t)T * 128 * 2;
constexpr size_t O_QB = O_VWT + (size_t)T * 128 * 2;
constexpr size_t O_KB = O_QB + (size_t)T * 512 * 2;
constexpr size_t O_VBT = O_KB + (size_t)T * 512 * 2;
constexpr size_t O_GBR = O_VBT + (size_t)T * 512 * 2;
constexpr size_t O_GA = O_GBR + (size_t)T * 2048 * 2;
constexpr size_t O_KCMP = O_GA + (size_t)T * 24 * 4;
constexpr size_t O_VCMPT = O_KCMP + (size_t)NB * 2 * 512 * 64 * 2;
constexpr size_t O_KMEAN = O_VCMPT + (size_t)NB * 2 * 512 * 64 * 2;
constexpr size_t O_YA = O_KMEAN + (size_t)NB * 8 * 32 * 64 * 2;
constexpr size_t O_YB = O_YA + (size_t)T * 512 * 2;
constexpr size_t WS_END = O_YB + (size_t)T * 512 * 2;
constexpr size_t O_BAR = WS_END;
constexpr size_t O_W2 = O_BAR + 16384;
constexpr size_t WSZ = O_ADA - O_WIN;
constexpr size_t WS_TOTAL = O_W2 + WSZ;
__host__ __device__ constexpr size_t wdl(int l) { return (l & 1) ? (O_W2 - O_WIN) : 0; }
constexpr size_t O_ACT = O_QA;
static_assert((size_t)T * DFF * 2 <= O_GA - O_QA, "ACT alias");

struct Params {
  const float* in[22];
  float* out;
  char* ws;
};

constexpr int SMEM_BYTES = 73728;

DI float xhalf_max(float v) { auto r = __builtin_amdgcn_permlane32_swap(__float_as_uint(v), __float_as_uint(v), false, false); return fmaxf(__uint_as_float(r[0]), __uint_as_float(r[1])); }
DI float xhalf_sum(float v) { auto r = __builtin_amdgcn_permlane32_swap(__float_as_uint(v), __float_as_uint(v), false, false); return __uint_as_float(r[0]) + __uint_as_float(r[1]); }
template <int CTRL> DI unsigned dpp_u(unsigned v) { return (unsigned)__builtin_amdgcn_update_dpp(0, (int)v, CTRL, 0xf, 0xf, true); }
DI float quad_sum(float v) { v += __uint_as_float(dpp_u<0xB1>(__float_as_uint(v))); v += __uint_as_float(dpp_u<0x4E>(__float_as_uint(v))); return v; }
DI int oct_sum(int v) { v += (int)dpp_u<0xB1>((unsigned)v); v += (int)dpp_u<0x4E>((unsigned)v); v += (int)dpp_u<0x141>((unsigned)v); return v; }
DI unsigned oct_or(unsigned v) { v |= dpp_u<0xB1>(v); v |= dpp_u<0x4E>(v); v |= dpp_u<0x141>(v); return v; }
DI int otid() { int t = threadIdx.x; asm volatile("" : "+v"(t)); return t; }
DI unsigned pk2(float a, float b) { f32x2 v = {a, b}; bf2_t r = __builtin_convertvector(v, bf2_t); return __builtin_bit_cast(unsigned, r); }
DI float bf_lo(unsigned u) { return __uint_as_float(u << 16); }
DI float bf_hi(unsigned u) { return __uint_as_float(u & 0xffff0000u); }
DI float bf2f(bf16_t h) { return __uint_as_float(((unsigned)h) << 16); }
DI int crow(int i, int h) { return (i & 3) + 8 * (i >> 2) + 4 * h; }
DI float sigmoidf_(float x) { return 1.f / (1.f + __expf(-x)); }
DI uint4 pack8(const float* v) { uint4 r; r.x = pk2(v[0], v[1]); r.y = pk2(v[2], v[3]); r.z = pk2(v[4], v[5]); r.w = pk2(v[6], v[7]); return r; }

DI int map_in(int n) {
  if (n < 1280) return n;
  if (n < 4864) return n + 24;
  if (n < 4888) return n - 4864 + 1280;
  return -1;
}
DI int map_ffi(int n) {
  const int tile = n >> 7, within = n & 127, wn = within >> 6, sub = within & 63, isup = sub >> 5, c = sub & 31;
  return (isup ? DFF : 0) + tile * 64 + wn * 32 + c;
}

template <int KT>
DI void conv_tile(const float* __restrict__ src, int srcN, int K, bf16_t* __restrict__ dst, int mode, int nt, int kg, char* smem) {
  float (*st)[65] = (float (*)[65])smem;
  const int tid = otid(), j = tid & 63, i0 = tid >> 6;
  const int n0 = nt * 64, k0 = kg * 64 * KT;
  int ns = n0 + j;
  if (mode == 1) ns = map_in(ns); else if (mode == 2) ns = map_ffi(ns);
  float v[KT * 16];
#pragma unroll
  for (int ii = 0; ii < KT * 16; ++ii) {
    const int k = i0 + 4 * ii;
    v[ii] = ns >= 0 ? src[(size_t)(k0 + k) * srcN + ns] : 0.f;
  }
#pragma unroll
  for (int ii = 0; ii < KT * 16; ++ii) st[i0 + 4 * ii][j] = v[ii];
  __syncthreads();
  const int nrow = tid >> 2, kc = (tid & 3) * 16;
#pragma unroll
  for (int sub = 0; sub < KT; ++sub) {
    float o[16];
#pragma unroll
    for (int q = 0; q < 16; ++q) o[q] = st[sub * 64 + kc + q][nrow];
    uint4* dp = (uint4*)(dst + (size_t)(n0 + nrow) * K + k0 + sub * 64 + kc);
    dp[0] = pack8(o);
    dp[1] = pack8(o + 8);
  }
  __syncthreads();
}

constexpr int CONV_TASKS = 78 * 4 + 32 + 32 + 64 + 88 * 4 + 16 * 11 + 16 + 16 + 1 + 1;

DI void conv_task(const Params& p, int l, int task, char* smem) {
  char* ws = p.ws + wdl(l);
  int t = task;
  if (t < 78 * 4) { conv_tile<4>(p.in[7] + (size_t)l * 1024 * NIN, NIN, 1024, (bf16_t*)(ws + O_WIN), 1, t % 78, t / 78, smem); return; }
  t -= 78 * 4;
  if (t < 32) { conv_tile<4>(p.in[17] + (size_t)l * 512 * 1024, 1024, 512, (bf16_t*)(ws + O_WUPA), 0, t % 16, t / 16, smem); return; }
  t -= 32;
  if (t < 32) { conv_tile<4>(p.in[18] + (size_t)l * 512 * 1024, 1024, 512, (bf16_t*)(ws + O_WUPB), 0, t % 16, t / 16, smem); return; }
  t -= 32;
  if (t < 64) { conv_tile<4>(p.in[19] + (size_t)l * 1024 * 1024, 1024, 1024, (bf16_t*)(ws + O_WOUT), 0, t % 16, t / 16, smem); return; }
  t -= 64;
  if (t < 88 * 4) { conv_tile<4>(p.in[20] + (size_t)l * 1024 * NFFI, NFFI, 1024, (bf16_t*)(ws + O_WFFI), 2, t % 88, t / 88, smem); return; }
  t -= 88 * 4;
  if (t < 16 * 11) { conv_tile<4>(p.in[21] + (size_t)l * DFF * 1024, 1024, DFF, (bf16_t*)(ws + O_WFFO), 0, t % 16, t / 16, smem); return; }
  t -= 16 * 11;
  if (t < 16) { conv_tile<4>(p.in[11] + (size_t)l * 2048 * 128, 128, 2048, (bf16_t*)(ws + O_CKW1), 0, t % 2, t / 2, smem); return; }
  t -= 16;
  if (t < 16) { conv_tile<4>(p.in[13] + (size_t)l * 2048 * 128, 128, 2048, (bf16_t*)(ws + O_CVW1), 0, t % 2, t / 2, smem); return; }
  t -= 16;
  if (t < 1) { conv_tile<2>(p.in[12] + (size_t)l * 128 * 64, 64, 128, (bf16_t*)(ws + O_CKW2), 0, 0, 0, smem); return; }
  conv_tile<2>(p.in[14] + (size_t)l * 128 * 64, 64, 128, (bf16_t*)(ws + O_CVW2), 0, 0, 0, smem);
}

DI void ada_task(const Params& p, int task, char* smem) {
  float* sc = (float*)smem;
  float* red = sc + 2048;
  const int tid = otid(), l = task / 96, n0 = (task % 96) * 64;
  for (int i = tid; i < 2048; i += 256) { const float c = p.in[1][i]; sc[i] = c / (1.f + __expf(-c)); }
  __syncthreads();
  const int j = tid & 63, kq = tid >> 6;
  const float* w = p.in[3] + ((size_t)l * 1024 + kq * 256) * 6144 + n0 + j;
  float a0 = 0.f, a1 = 0.f;
#pragma unroll 8
  for (int k = 0; k < 256; ++k) { const float wv = w[(size_t)k * 6144]; a0 += sc[kq * 256 + k] * wv; a1 += sc[1024 + kq * 256 + k] * wv; }
  red[(kq * 2 + 0) * 64 + j] = a0; red[(kq * 2 + 1) * 64 + j] = a1;
  __syncthreads();
  if (tid < 128) {
    const int b = tid >> 6;
    float s = red[(0 * 2 + b) * 64 + j] + red[(1 * 2 + b) * 64 + j] + red[(2 * 2 + b) * 64 + j] + red[(3 * 2 + b) * 64 + j];
    ((float*)(p.ws + O_ADA))[((size_t)l * 2 + b) * 6144 + n0 + j] = s + p.in[4][(size_t)l * 6144 + n0 + j];
  }
  __syncthreads();
}

DI void rope_task(const Params& p, int task) {
  const int tid = otid(), row = task * 8 + (tid >> 5), i = tid & 31;
  const int pos = ((const int*)p.in[2])[row];
  const float inv = 1.0f / powf(10000.0f, (float)(2 * i) / 64.0f);
  const float ang = (float)pos * inv;
  ((float*)(p.ws + O_COS))[(size_t)row * 32 + i] = cosf(ang);
  ((float*)(p.ws + O_SIN))[(size_t)row * 32 + i] = sinf(ang);
}

DI void norm_rows(const float* __restrict__ xin, const float* __restrict__ gn, const float* __restrict__ ada_sh, const float* __restrict__ ada_sc,
                  bf16_t* __restrict__ H) {
  const int tid_ = otid(), lane = tid_ & 63, w = tid_ >> 6;
  const int nw = gridDim.x * 4;
  for (int row0 = (blockIdx.x * 4 + w) * 4; row0 < T; row0 += nw * 4) {
    const int b = row0 / S;
    float4 v[4][4];
#pragma unroll
    for (int r = 0; r < 4; ++r)
#pragma unroll
      for (int i = 0; i < 4; ++i) v[r][i] = *(const float4*)(xin + (size_t)(row0 + r) * 1024 + (lane + 64 * i) * 4);
    float4 gk[4], sh[4];
#pragma unroll
    for (int i = 0; i < 4; ++i) {
      const int col = (lane + 64 * i) * 4;
      const float4 g = *(const float4*)(gn + col);
      const float4 sc = *(const float4*)(ada_sc + (size_t)b * 6144 + col);
      sh[i] = *(const float4*)(ada_sh + (size_t)b * 6144 + col);
      gk[i].x = g.x * (1.f + sc.x); gk[i].y = g.y * (1.f + sc.y); gk[i].z = g.z * (1.f + sc.z); gk[i].w = g.w * (1.f + sc.w);
    }
    float ss[4];
#pragma unroll
    for (int r = 0; r < 4; ++r) {
      ss[r] = 0.f;
#pragma unroll
      for (int i = 0; i < 4; ++i) ss[r] += v[r][i].x * v[r][i].x + v[r][i].y * v[r][i].y + v[r][i].z * v[r][i].z + v[r][i].w * v[r][i].w;
    }
#pragma unroll
    for (int o = 32; o >= 1; o >>= 1) {
#pragma unroll
      for (int r = 0; r < 4; ++r) ss[r] += __shfl_xor(ss[r], o);
    }
#pragma unroll
    for (int r = 0; r < 4; ++r) {
      const float rr = rsqrtf(ss[r] * (1.f / 1024.f) + 1e-6f);
#pragma unroll
      for (int i = 0; i < 4; ++i) {
        const int col = (lane + 64 * i) * 4;
        uint2 o;
        o.x = pk2(v[r][i].x * rr * gk[i].x + sh[i].x, v[r][i].y * rr * gk[i].y + sh[i].y);
        o.y = pk2(v[r][i].z * rr * gk[i].z + sh[i].z, v[r][i].w * rr * gk[i].w + sh[i].w);
        *(uint2*)(H + (size_t)(row0 + r) * 1024 + col) = o;
      }
    }
  }
}

DI void qk_epilogue(const float* st  , int m0, const float* __restrict__ gain, float scale, bf16_t* __restrict__ dst, int dstride, int dcol0,
                    const float* __restrict__ COS, const float* __restrict__ SIN) {
  const int tid = otid(), row = tid & 127, hd = tid >> 7;
  const float* sp = st + row * 132 + hd * 64;
  float ss = 0.f;
#pragma unroll 4
  for (int j = 0; j < 64; j += 4) { const float4 v = *(const float4*)(sp + j); ss += v.x * v.x + v.y * v.y + v.z * v.z + v.w * v.w; }
  const float rr = rsqrtf(ss * (1.f / 64.f) + 1e-6f);
  const size_t tok = (size_t)(m0 + row);
  bf16_t* dp = dst + tok * dstride + dcol0 + hd * 64;
#pragma unroll 1
  for (int j = 0; j < 32; j += 8) {
    float o1[8], o2[8];
#pragma unroll
    for (int q = 0; q < 8; ++q) {
      const float x1 = sp[j + q] * rr * gain[j + q], x2 = sp[j + q + 32] * rr * gain[j + q + 32];
      const float cs = COS[tok * 32 + j + q], sn = SIN[tok * 32 + j + q];
      o1[q] = (x1 * cs - x2 * sn) * scale;
      o2[q] = (x2 * cs + x1 * sn) * scale;
    }
    *(uint4*)(dp + j) = pack8(o1);
    *(uint4*)(dp + j + 32) = pack8(o2);
  }
}
DI void raw_epilogue(const float* st, int m0, bf16_t* __restrict__ dst, int dstride, int dcol0, bool sig) {
  const int tid = otid(), row = tid & 127, hd = tid >> 7;
  const float* sp = st + row * 132 + hd * 64;
  bf16_t* dp = dst + (size_t)(m0 + row) * dstride + dcol0 + hd * 64;
#pragma unroll 2
  for (int j = 0; j < 64; j += 8) {
    float o[8];
#pragma unroll
    for (int q = 0; q < 8; ++q) { const float v = sp[j + q]; o[q] = sig ? sigmoidf_(v) : v; }
    *(uint4*)(dp + j) = pack8(o);
  }
}
DI void vt_epilogue(const float* st, int m0, bf16_t* __restrict__ dst, int nheads, int head0) {
  const int tid = otid(), col = tid & 127, rh = tid >> 7;
  const int b = m0 / S, s0 = m0 % S, hd = head0 + (col >> 6), d = col & 63;
  bf16_t* dp = dst + ((size_t)(b * nheads + hd) * 64 + d) * S + s0 + rh * 64;
#pragma unroll 2
  for (int r8 = 0; r8 < 8; ++r8) {
    float o[8];
#pragma unroll
    for (int q = 0; q < 8; ++q) o[q] = st[(rh * 64 + r8 * 8 + q) * 132 + col];
    *(uint4*)(dp + r8 * 8) = pack8(o);
  }
}


DI void gemm_mainloop_big(const bf16_t* __restrict__ A, int lda, const bf16_t* __restrict__ Bt, int ldb, int K, int m0, int n0,
                          f32x16 (&acc)[4][2], char* smem) {
  bf16_t (*sa)[72] = (bf16_t (*)[72])smem;
  bf16_t (*sb)[72] = (bf16_t (*)[72])(smem + 256 * 72 * 2);
  const int tid = otid(), lane = tid & 63, w = tid >> 6, wm = w >> 1, wn = w & 1;
  const int r = lane & 31, half = lane >> 5;
  const int nk = K >> 6;
  u32x4 ra[8], rb[4];
  const bf16_t* ap = A + (size_t)(m0 + (tid >> 3)) * lda + (tid & 7) * 8;
  const bf16_t* bp = Bt + (size_t)(n0 + (tid >> 3)) * ldb + (tid & 7) * 8;
#pragma unroll
  for (int i = 0; i < 8; ++i) ra[i] = *(const u32x4*)(ap + (size_t)(32 * i) * lda);
#pragma unroll
  for (int i = 0; i < 4; ++i) rb[i] = *(const u32x4*)(bp + (size_t)(32 * i) * ldb);
  __syncthreads();
#pragma unroll
  for (int i = 0; i < 8; ++i) *(u32x4*)&sa[(tid >> 3) + 32 * i][(tid & 7) * 8] = ra[i];
#pragma unroll
  for (int i = 0; i < 4; ++i) *(u32x4*)&sb[(tid >> 3) + 32 * i][(tid & 7) * 8] = rb[i];
  __syncthreads();
  for (int kt = 0; kt < nk; ++kt) {
    if (kt + 1 < nk) {
#pragma unroll
      for (int i = 0; i < 8; ++i) ra[i] = *(const u32x4*)(ap + (size_t)(32 * i) * lda + (kt + 1) * 64);
#pragma unroll
      for (int i = 0; i < 4; ++i) rb[i] = *(const u32x4*)(bp + (size_t)(32 * i) * ldb + (kt + 1) * 64);
    }
#pragma unroll
    for (int ks = 0; ks < 4; ++ks) {
      bf16x8 af[4], bfr[2];
#pragma unroll
      for (int f = 0; f < 4; ++f) af[f] = *(const bf16x8*)&sa[wm * 128 + f * 32 + r][ks * 16 + half * 8];
#pragma unroll
      for (int f = 0; f < 2; ++f) bfr[f] = *(const bf16x8*)&sb[wn * 64 + f * 32 + r][ks * 16 + half * 8];
#pragma unroll
      for (int mf = 0; mf < 4; ++mf)
#pragma unroll
        for (int nf = 0; nf < 2; ++nf) acc[mf][nf] = MFMA32(af[mf], bfr[nf], acc[mf][nf]);
    }
    __syncthreads();
    if (kt + 1 < nk) {
#pragma unroll
      for (int i = 0; i < 8; ++i) *(u32x4*)&sa[(tid >> 3) + 32 * i][(tid & 7) * 8] = ra[i];
#pragma unroll
      for (int i = 0; i < 4; ++i) *(u32x4*)&sb[(tid >> 3) + 32 * i][(tid & 7) * 8] = rb[i];
    }
    __syncthreads();
  }
}
DI void zero_acc_big(f32x16 (&acc)[4][2]) {
#pragma unroll
  for (int a = 0; a < 4; ++a)
#pragma unroll
    for (int b = 0; b < 2; ++b)
#pragma unroll
      for (int i = 0; i < 16; ++i) acc[a][b][i] = 0.f;
}
DI void stage_half(float* st, const f32x16 (&acc)[4][2], int h, int tid) {
  const int lane = tid & 63, w = tid >> 6, wm = w >> 1, wn = w & 1, c = lane & 31, half = lane >> 5;
  if (wm == h) {
#pragma unroll
    for (int mf = 0; mf < 4; ++mf)
#pragma unroll
      for (int nf = 0; nf < 2; ++nf)
#pragma unroll
        for (int i = 0; i < 16; ++i) st[(mf * 32 + crow(i, half)) * 132 + wn * 64 + nf * 32 + c] = acc[mf][nf][i];
  }
}
DI bool gemm_coords_big(int idx, int NT, int& mt, int& nt) {
  const int x = idx & 7, q = idx >> 3, om = q >> 6, qq = q & 63;
  const int macro = om * 8 + x, Mb = macro & 7, Nb = macro >> 3;
  mt = Mb * 8 + (qq & 7); nt = Nb * 8 + (qq >> 3);
  return nt < NT;
}
DI int gemm_slots_big(int NT) { return 8 * ((NT + 7) / 8) * 64; }

DI void in_epilogue_half(const Params& p, int l, const float* st, int m0, int nt) {
  char* ws = p.ws;
  const float* COS = (const float*)(ws + O_COS);
  const float* SIN = (const float*)(ws + O_SIN);
  if (nt < 4) qk_epilogue(st, m0, p.in[8] + l * 64, 0.125f, (bf16_t*)(ws + O_QA), 512, nt * 128, COS, SIN);
  else if (nt == 4) raw_epilogue(st, m0, (bf16_t*)(ws + O_KC), 128, 0, false);
  else if (nt == 5) raw_epilogue(st, m0, (bf16_t*)(ws + O_VC), 128, 0, false);
  else if (nt == 6) qk_epilogue(st, m0, p.in[9] + l * 64, 1.f, (bf16_t*)(ws + O_KS), 128, 0, COS, SIN);
  else if (nt == 7) vt_epilogue(st, m0, (bf16_t*)(ws + O_VST), 2, 0);
  else if (nt == 8) qk_epilogue(st, m0, p.in[9] + l * 64, 1.f, (bf16_t*)(ws + O_KW), 128, 0, COS, SIN);
  else if (nt == 9) vt_epilogue(st, m0, (bf16_t*)(ws + O_VWT), 2, 0);
  else if (nt < 14) qk_epilogue(st, m0, p.in[15] + l * 64, 0.125f, (bf16_t*)(ws + O_QB), 512, (nt - 10) * 128, COS, SIN);
  else if (nt < 18) qk_epilogue(st, m0, p.in[16] + l * 64, 1.f, (bf16_t*)(ws + O_KB), 512, (nt - 14) * 128, COS, SIN);
  else if (nt < 22) vt_epilogue(st, m0, (bf16_t*)(ws + O_VBT), 8, (nt - 18) * 2);
  else if (nt < 38) raw_epilogue(st, m0, (bf16_t*)(ws + O_GBR), 2048, (nt - 22) * 128, true);
  else {
    const int tid = otid();
    if (tid < 128) {
      float* gp = (float*)(ws + O_GA) + (size_t)(m0 + tid) * 24;
#pragma unroll
      for (int j = 0; j < 24; ++j) gp[j] = sigmoidf_(st[tid * 132 + j]);
    }
  }
}
DI void gemm_in_tile_big(const Params& p, int l, int mt, int nt, char* smem) {
  char* ws = p.ws;
  f32x16 acc[4][2];
  zero_acc_big(acc);
  const int m0 = mt * 256, n0 = nt * 128;
  gemm_mainloop_big((const bf16_t*)(ws + O_H), 1024, (const bf16_t*)(ws + wdl(l) + O_WIN), 1024, 1024, m0, n0, acc, smem);
  float* st = (float*)smem;
#pragma unroll
  for (int h = 0; h < 2; ++h) {
    stage_half(st, acc, h, otid());
    __syncthreads();
    in_epilogue_half(p, l, st, m0 + h * 128, nt);
    __syncthreads();
  }
}
DI void gemm_res_tile_big(const bf16_t* A, int lda, const bf16_t* Bt, int K, const float* __restrict__ xin, float* __restrict__ xout,
                          const float* __restrict__ gate, int mt, int nt, char* smem) {
  const int m0 = mt * 256, n0 = nt * 128;
  f32x16 acc[4][2];
  zero_acc_big(acc);
  gemm_mainloop_big(A, lda, Bt, K, K, m0, n0, acc, smem);
  float* st = (float*)smem;
  const int b = m0 / S;
#pragma unroll
  for (int h = 0; h < 2; ++h) {
    const int tid = otid();
    stage_half(st, acc, h, tid);
    __syncthreads();
    const int r = tid >> 5, ch = tid & 31;
    const float4 g = *(const float4*)(gate + (size_t)b * 6144 + n0 + ch * 4);
#pragma unroll 4
    for (int ps = 0; ps < 16; ++ps) {
      const int row = ps * 8 + r;
      const float4 a = *(const float4*)(st + row * 132 + ch * 4);
      const size_t off = (size_t)(m0 + h * 128 + row) * 1024 + n0 + ch * 4;
      const float4 xi = *(const float4*)(xin + off);
      float4 o; o.x = xi.x + g.x * a.x; o.y = xi.y + g.y * a.y; o.z = xi.z + g.z * a.z; o.w = xi.w + g.w * a.w;
      *(float4*)(xout + off) = o;
    }
    __syncthreads();
  }
}
DI void gemm_ffi_tile_big(const Params& p, int l, int mt, int nt, char* smem) {
  char* ws = p.ws;
  const int m0 = mt * 256, n0 = nt * 128;
  f32x16 acc[4][2];
  zero_acc_big(acc);
  gemm_mainloop_big((const bf16_t*)(ws + O_H), 1024, (const bf16_t*)(ws + wdl(l) + O_WFFI), 1024, 1024, m0, n0, acc, smem);
  bf16_t* ACT = (bf16_t*)(ws + O_ACT);
  bf16_t (*sbt)[72] = (bf16_t (*)[72])smem;
  const int tid = otid(), lane = tid & 63, w = tid >> 6, wm = w >> 1, wn = w & 1, c = lane & 31, half = lane >> 5;
#pragma unroll
  for (int mf = 0; mf < 4; ++mf)
#pragma unroll
    for (int i = 0; i < 16; ++i) {
      const float g = acc[mf][0][i], u = acc[mf][1][i];
      const float a = g / (1.f + __expf(-g)) * u;
      sbt[wm * 128 + mf * 32 + crow(i, half)][wn * 32 + c] = (bf16_t)(pk2(a, 0.f) & 0xffff);
    }
  __syncthreads();
  const int r = tid >> 3, ch = tid & 7;
#pragma unroll
  for (int ps = 0; ps < 8; ++ps) {
    const int row = ps * 32 + r;
    *(u32x4*)(ACT + (size_t)(m0 + row) * DFF + nt * 64 + ch * 8) = *(const u32x4*)&sbt[row][ch * 8];
  }
  __syncthreads();
}
DI void gemm_up_pass_big(const bf16_t* Y, const bf16_t* W, const bf16_t* __restrict__ GBR, int gcol0, bf16_t* __restrict__ MG, bool first,
                         int mt, int nt, char* smem) {
  const int m0 = mt * 256, n0 = nt * 128;
  f32x16 acc[4][2];
  zero_acc_big(acc);
  gemm_mainloop_big(Y, 512, W, 512, 512, m0, n0, acc, smem);
  float* st = (float*)smem;
#pragma unroll
  for (int h = 0; h < 2; ++h) {
    const int tid = otid();
    stage_half(st, acc, h, tid);
    __syncthreads();
    const int r = tid >> 4, ch = tid & 15;
#pragma unroll 2
    for (int ps = 0; ps < 8; ++ps) {
      const int row = ps * 16 + r;
      const float4 a0 = *(const float4*)(st + row * 132 + ch * 8), a1 = *(const float4*)(st + row * 132 + ch * 8 + 4);
      const size_t grow = (size_t)(m0 + h * 128 + row);
      const u32x4 gv = *(const u32x4*)(GBR + grow * 2048 + gcol0 + n0 + ch * 8);
      float v[8];
      v[0] = bf_lo(gv.x) * a0.x; v[1] = bf_hi(gv.x) * a0.y; v[2] = bf_lo(gv.y) * a0.z; v[3] = bf_hi(gv.y) * a0.w;
      v[4] = bf_lo(gv.z) * a1.x; v[5] = bf_hi(gv.z) * a1.y; v[6] = bf_lo(gv.w) * a1.z; v[7] = bf_hi(gv.w) * a1.w;
      bf16_t* mp = MG + grow * 1024 + n0 + ch * 8;
      if (!first) {
        const u32x4 pv = *(const u32x4*)mp;
        v[0] += bf_lo(pv.x); v[1] += bf_hi(pv.x); v[2] += bf_lo(pv.y); v[3] += bf_hi(pv.y);
        v[4] += bf_lo(pv.z); v[5] += bf_hi(pv.z); v[6] += bf_lo(pv.w); v[7] += bf_hi(pv.w);
      }
      u32x4 ov; ov.x = pk2(v[0], v[1]); ov.y = pk2(v[2], v[3]); ov.z = pk2(v[4], v[5]); ov.w = pk2(v[6], v[7]);
      *(u32x4*)mp = ov;
    }
    __syncthreads();
  }
}

DI float gelu_tanh(float x) {
  const float u = 0.7978845608028654f * (x + 0.044715f * x * x * x);
  const float e = __expf(2.f * u);
  const float th = 1.f - 2.f / (e + 1.f);
  return 0.5f * x * (1.f + th);
}

DI void cmp_tile(const Params& p, int l, int tile, char* smem) {
  char* ws = p.ws;
  const int kv = tile & 1, bg = (tile >> 1) & 3, nb = tile >> 3, b = bg >> 1, g = bg & 1;
  const int tid = otid(), lane = tid & 63, w = tid >> 6, r = lane & 31, half = lane >> 5;
  const bf16_t* src = (const bf16_t*)(ws + (kv ? O_VC : O_KC));
  const bf16_t* W1T = (const bf16_t*)(ws + wdl(l) + (kv ? O_CVW1 : O_CKW1));
  const bf16_t* W2T = (const bf16_t*)(ws + wdl(l) + (kv ? O_CVW2 : O_CKW2));
  const float* pe = p.in[10] + (size_t)l * 32 * 64;
  bf16_t (*hid)[136] = (bf16_t (*)[136])smem;
  float (*outf)[68] = (float (*)[68])(smem + 8704);
  int n = nb * 32 + r; if (n > 510) n = 510;
  const bf16_t* arow = src + ((size_t)b * S + 16 * n) * 128 + g * 64 + half * 8;
  float (*part)[32][128] = (float (*)[32][128])smem;
  f32x16 acc[4];
#pragma unroll
  for (int nf = 0; nf < 4; ++nf)
#pragma unroll
    for (int i = 0; i < 16; ++i) acc[nf][i] = 0.f;
  const bf16_t* brow = W1T + (size_t)r * 2048 + half * 8;
#pragma unroll 4
  for (int t8 = 0; t8 < 8; ++t8) {
    const int tl = 8 * w + t8;
#pragma unroll
    for (int dk = 0; dk < 4; ++dk) {
      const uint4 av = *(const uint4*)(arow + (size_t)tl * 128 + dk * 16);
      const float4 p0 = *(const float4*)(pe + tl * 64 + dk * 16 + half * 8);
      const float4 p1 = *(const float4*)(pe + tl * 64 + dk * 16 + half * 8 + 4);
      uint4 a2;
      a2.x = pk2(bf_lo(av.x) + p0.x, bf_hi(av.x) + p0.y);
      a2.y = pk2(bf_lo(av.y) + p0.z, bf_hi(av.y) + p0.w);
      a2.z = pk2(bf_lo(av.z) + p1.x, bf_hi(av.z) + p1.y);
      a2.w = pk2(bf_lo(av.w) + p1.z, bf_hi(av.w) + p1.w);
      const bf16x8 a8 = __builtin_bit_cast(bf16x8, a2);
#pragma unroll
      for (int nf = 0; nf < 4; ++nf) {
        const bf16x8 bv = *(const bf16x8*)(brow + (size_t)(nf * 32) * 2048 + tl * 64 + dk * 16);
        acc[nf] = MFMA32(a8, bv, acc[nf]);
      }
    }
  }
  __syncthreads();
#pragma unroll
  for (int nf = 0; nf < 4; ++nf)
#pragma unroll
    for (int i = 0; i < 16; ++i) part[w][crow(i, half)][nf * 32 + r] = acc[nf][i];
  __syncthreads();
  float hv[16];
#pragma unroll
  for (int e = 0; e < 16; ++e) {
    const int idx = tid + 256 * e, row = idx >> 7, col = idx & 127;
    hv[e] = gelu_tanh((part[0][row][col] + part[1][row][col]) + (part[2][row][col] + part[3][row][col]));
  }
  __syncthreads();
#pragma unroll
  for (int e = 0; e < 16; ++e) {
    const int idx = tid + 256 * e, row = idx >> 7, col = idx & 127;
    hid[row][col] = (bf16_t)(pk2(hv[e], 0.f) & 0xffff);
  }
  __syncthreads();
  if (w < 2) {
    f32x16 a2;
#pragma unroll
    for (int i = 0; i < 16; ++i) a2[i] = 0.f;
#pragma unroll
    for (int ks = 0; ks < 8; ++ks) {
      const bf16x8 av = *(const bf16x8*)&hid[r][ks * 16 + half * 8];
      const bf16x8 bv = *(const bf16x8*)(W2T + (size_t)(32 * w + r) * 128 + ks * 16 + half * 8);
      a2 = MFMA32(av, bv, a2);
    }
#pragma unroll
    for (int i = 0; i < 16; ++i) outf[crow(i, half)][32 * w + r] = a2[i];
  }
  __syncthreads();
  if (kv == 0) {
    const int row = tid >> 3, part = tid & 7, nn = nb * 32 + row;
    float ss = 0.f;
#pragma unroll
    for (int q = 0; q < 8; ++q) { const float v = outf[row][part * 8 + q]; ss += v * v; }
    ss += __shfl_xor(ss, 1); ss += __shfl_xor(ss, 2); ss += __shfl_xor(ss, 4);
    const float rr = rsqrtf(ss * (1.f / 64.f) + 1e-6f);
    const int j0 = (part & 3) * 8, hi = part >> 2;
    const float* gain = p.in[9] + l * 64;
    const int nc = nn > 510 ? 510 : nn;
    const size_t prow = (size_t)b * S + 16 * nc + 31;
    const float* COS = (const float*)(ws + O_COS) + prow * 32;
    const float* SIN = (const float*)(ws + O_SIN) + prow * 32;
    float o[8];
#pragma unroll
    for (int q = 0; q < 8; ++q) {
      const float x1 = outf[row][j0 + q] * rr * gain[j0 + q], x2 = outf[row][j0 + q + 32] * rr * gain[j0 + q + 32];
      const float cs = COS[j0 + q], sn = SIN[j0 + q];
      const float v = hi ? (x2 * cs + x1 * sn) : (x1 * cs - x2 * sn);
      o[q] = nn > 510 ? 0.f : v;
    }
    *(uint4*)((bf16_t*)(ws + O_KCMP) + ((size_t)(b * 2 + g) * 512 + nn) * 64 + hi * 32 + j0) = pack8(o);
  } else {
    const int d = tid & 63, ng = tid >> 6;
    float o[8];
#pragma unroll
    for (int q = 0; q < 8; ++q) { const int nn = nb * 32 + ng * 8 + q; o[q] = nn > 510 ? 0.f : outf[ng * 8 + q][d]; }
    *(uint4*)((bf16_t*)(ws + O_VCMPT) + ((size_t)(b * 2 + g) * 64 + d) * 512 + nb * 32 + ng * 8) = pack8(o);
  }
  __syncthreads();
}

DI void kmean_task(const Params& p, int task, char* smem) {
  char* ws = p.ws;
  float* red = (float*)smem;
  const int tid = otid(), cq = task & 3, blk = (task >> 2) & 31, b = task >> 7;
  const int cp = tid & 63, tq = tid >> 6;
  const bf16_t* kp = (const bf16_t*)(ws + O_KB) + ((size_t)b * S + blk * 256 + tq * 64) * 512 + cq * 128 + cp * 2;
  float a0 = 0.f, a1 = 0.f;
#pragma unroll 8
  for (int k = 0; k < 64; ++k) { const unsigned u = *(const unsigned*)(kp + (size_t)k * 512); a0 += bf_lo(u); a1 += bf_hi(u); }
  red[tq * 128 + cp * 2] = a0; red[tq * 128 + cp * 2 + 1] = a1;
  __syncthreads();
  if (tid < 128) {
    const float s = (red[tid] + red[128 + tid] + red[256 + tid] + red[384 + tid]) * (1.f / 256.f);
    const int col = cq * 128 + tid, h = col >> 6, d = col & 63;
    ((bf16_t*)(ws + O_KMEAN))[((size_t)(b * 8 + h) * 32 + blk) * 64 + d] = (bf16_t)(pk2(s, 0.f) & 0xffff);
  }
  __syncthreads();
}

struct AttnSmem {
  bf16_t k[2][64][72];
  bf16_t vt[2][64][72];
  float imp[32][136];
  unsigned selmask[32][4];
};
static_assert(sizeof(AttnSmem) <= SMEM_BYTES, "smem");

DI void ld_tile(int tid, const bf16_t* __restrict__ kp, int kstride, const bf16_t* __restrict__ vp, int vstride, u32x4 (&r)[4]) {
#pragma unroll
  for (int i = 0; i < 2; ++i) {
    const int id = tid + 256 * i, row = id >> 3, c = id & 7;
    r[i] = *(const u32x4*)(kp + (size_t)row * kstride + c * 8);
    r[2 + i] = *(const u32x4*)(vp + (size_t)row * vstride + c * 8);
  }
}
DI void st_tile(int tid, AttnSmem& sm, int buf, const u32x4 (&r)[4]) {
#pragma unroll
  for (int i = 0; i < 2; ++i) {
    const int id = tid + 256 * i, row = id >> 3, c = id & 7;
    *(u32x4*)&sm.k[buf][row][c * 8] = r[i];
    *(u32x4*)&sm.vt[buf][row][c * 8] = r[2 + i];
  }
}

template <class Body>
DI void kv_loop(int tid, AttnSmem& sm, const bf16_t* kp, int kstride, const bf16_t* vp, int vstride, int tlo, int thi, Body body) {
  const int n = thi - tlo;
  if (n <= 0) return;
  u32x4 r0[4], r1[4];
  ld_tile(tid, kp + (size_t)tlo * 64 * kstride, kstride, vp + (size_t)tlo * 64, vstride, r0);
  if (n > 1) ld_tile(tid, kp + (size_t)(tlo + 1) * 64 * kstride, kstride, vp + (size_t)(tlo + 1) * 64, vstride, r1);
  __syncthreads();
  st_tile(tid, sm, 0, r0);
  __syncthreads();
  for (int i = 0; i < n; i += 2) {
    if (i + 2 < n) ld_tile(tid, kp + (size_t)(tlo + i + 2) * 64 * kstride, kstride, vp + (size_t)(tlo + i + 2) * 64, vstride, r0);
    body(tlo + i, 0);
    if (i + 1 < n) st_tile(tid, sm, 1, r1);
    __syncthreads();
    if (i + 1 >= n) break;
    if (i + 3 < n) ld_tile(tid, kp + (size_t)(tlo + i + 3) * 64 * kstride, kstride, vp + (size_t)(tlo + i + 3) * 64, vstride, r1);
    body(tlo + i + 1, 1);
    if (i + 2 < n) st_tile(tid, sm, 0, r0);
    __syncthreads();
  }
}

DI void qk_scores(int lane, const bf16_t (*sk)[72], int kk, const bf16x8 (&q)[4], f32x16& s) {
  const int r = lane & 31, half = lane >> 5;
  const int pr = (r & 0x13) | ((r & 4) << 1) | ((r & 8) >> 1);
#pragma unroll
  for (int i = 0; i < 16; ++i) s[i] = 0.f;
#pragma unroll
  for (int ks = 0; ks < 4; ++ks) {
    const bf16x8 a = *(const bf16x8*)&sk[kk * 32 + pr][ks * 16 + half * 8];
    s = MFMA32(a, q[ks], s);
  }
}

DI float max16(const f32x16& s) {
  float m = s[0];
#pragma unroll
  for (int j = 1; j < 16; ++j) m = fmaxf(m, s[j]);
  return m;
}
DI f32x2 mk2(float a, float b) { f32x2 r = {a, b}; return r; }
template <bool ELEM>
DI void attn_step64(int lane, const bf16_t (*sk)[72], const bf16_t (*svt)[72], const bf16x8 (&q)[4], f32x16 (&o)[2], float& m, float& l,
                    bool lane_on, int key0, int lo, int hi) {
  const int r = lane & 31, half = lane >> 5;
  const int pr = (r & 0x13) | ((r & 4) << 1) | ((r & 8) >> 1);
  f32x16 s0, s1;
#pragma unroll
  for (int i = 0; i < 16; ++i) { s0[i] = 0.f; s1[i] = 0.f; }
#pragma unroll
  for (int ks = 0; ks < 4; ++ks) {
    const bf16x8 a0 = *(const bf16x8*)&sk[pr][ks * 16 + half * 8];
    const bf16x8 a1 = *(const bf16x8*)&sk[32 + pr][ks * 16 + half * 8];
    s0 = MFMA32(a0, q[ks], s0);
    s1 = MFMA32(a1, q[ks], s1);
  }
  if (ELEM) {
#pragma unroll
    for (int i = 0; i < 16; ++i) {
      const int key = key0 + (i & 7) + 8 * half + 16 * (i >> 3);
      const bool ok0 = lane_on && key >= lo && key <= hi;
      const bool ok1 = lane_on && (key + 32) >= lo && (key + 32) <= hi;
      s0[i] = ok0 ? s0[i] : NEGF;
      s1[i] = ok1 ? s1[i] : NEGF;
    }
  }
  float mx = fmaxf(max16(s0), max16(s1));
  if (!ELEM && !lane_on) mx = NEGF;
  mx = xhalf_max(mx);
  const bool upd = (mx - m) * L2E > 8.f;
  if (__any(upd)) {
    const float mnew = upd ? mx : m;
    const float alpha = __builtin_amdgcn_exp2f((m - mnew) * L2E);
    l *= alpha;
    m = mnew;
    const f32x2 al2 = mk2(alpha, alpha);
#pragma unroll
    for (int mt = 0; mt < 2; ++mt)
#pragma unroll
      for (int i = 0; i < 16; i += 2) { f32x2 v = mk2(o[mt][i], o[mt][i + 1]); v = v * al2; o[mt][i] = v.x; o[mt][i + 1] = v.y; }
  }
  float mb = (m < -1e29f) ? 0.f : m * L2E;
  if (!ELEM && !lane_on) mb = __builtin_inff();
  const f32x2 l2e2 = mk2(L2E, L2E), nmb2 = mk2(-mb, -mb);
  f32x2 sum0 = mk2(0.f, 0.f), sum1 = mk2(0.f, 0.f);
#pragma unroll
  for (int i = 0; i < 16; i += 2) {
    f32x2 v0 = __builtin_elementwise_fma(mk2(s0[i], s0[i + 1]), l2e2, nmb2);
    f32x2 v1 = __builtin_elementwise_fma(mk2(s1[i], s1[i + 1]), l2e2, nmb2);
    v0.x = __builtin_amdgcn_exp2f(v0.x); v0.y = __builtin_amdgcn_exp2f(v0.y);
    v1.x = __builtin_amdgcn_exp2f(v1.x); v1.y = __builtin_amdgcn_exp2f(v1.y);
    sum0 += v0; sum1 += v1;
    s0[i] = v0.x; s0[i + 1] = v0.y; s1[i] = v1.x; s1[i + 1] = v1.y;
  }
  sum0 += sum1;
  l += sum0.x + sum0.y;
#pragma unroll
  for (int j = 0; j < 4; ++j) {
    uint4 pu;
    if (j < 2) { pu.x = pk2(s0[8 * j], s0[8 * j + 1]); pu.y = pk2(s0[8 * j + 2], s0[8 * j + 3]); pu.z = pk2(s0[8 * j + 4], s0[8 * j + 5]); pu.w = pk2(s0[8 * j + 6], s0[8 * j + 7]); }
    else { const int jj = j - 2; pu.x = pk2(s1[8 * jj], s1[8 * jj + 1]); pu.y = pk2(s1[8 * jj + 2], s1[8 * jj + 3]); pu.z = pk2(s1[8 * jj + 4], s1[8 * jj + 5]); pu.w = pk2(s1[8 * jj + 6], s1[8 * jj + 7]); }
    const bf16x8 pb = __builtin_bit_cast(bf16x8, pu);
#pragma unroll
    for (int mt = 0; mt < 2; ++mt) {
      const bf16x8 a = *(const bf16x8*)&svt[mt * 32 + r][j * 16 + half * 8];
      o[mt] = MFMA32(a, pb, o[mt]);
    }
  }
}

DI void zero_o(f32x16 (&o)[2]) {
#pragma unroll
  for (int a = 0; a < 2; ++a)
#pragma unroll
    for (int i = 0; i < 16; ++i) o[a][i] = 0.f;
}

DI void nsa_tile(const Params& p, int rank, char* smem) {
  char* ws = p.ws;
  AttnSmem& sm = *(AttnSmem*)smem;
  const int bg = rank & 3, b = bg >> 1, g = bg & 1, t0 = (255 - (rank >> 2)) * 32;
  const int tid = otid(), lane = tid & 63, w = tid >> 6, c = lane & 31, half = lane >> 5;
  const int tokl = w * 8 + (c >> 2), hh = c & 3, t = t0 + tokl, head = g * 4 + hh;
  __syncthreads();
  for (int i = tid; i < 32 * 136; i += 256) (&sm.imp[0][0])[i] = 0.f;
  bf16x8 q[4];
  {
    const bf16_t* qp = (const bf16_t*)(ws + O_QA) + ((size_t)b * S + t) * 512 + head * 64 + half * 8;
#pragma unroll
    for (int ks = 0; ks < 4; ++ks) q[ks] = *(const bf16x8*)(qp + ks * 16);
  }
  const float* gap = (const float*)(ws + O_GA) + ((size_t)b * S + t) * 24 + head * 3;
  const float g0 = gap[0], g1 = gap[1], g2 = gap[2];
  f32x16 y[2];
  zero_o(y);

  {
    const int nlim = (t - 31) >> 4;
    const int ntile = ((t0 >> 4) >> 6) + 1;
    const bf16_t* kp = (const bf16_t*)(ws + O_KCMP) + (size_t)(b * 2 + g) * 512 * 64;
    const bf16_t* vp = (const bf16_t*)(ws + O_VCMPT) + (size_t)(b * 2 + g) * 64 * 512;
    f32x16 o[2];
    zero_o(o);
    float m = NEGF, l = 0.f;
    kv_loop(tid, sm, kp, 64, vp, 512, 0, ntile, [&](int it, int buf) {
      attn_step64<true>(lane, sm.k[buf], sm.vt[buf], q, o, m, l, true, it * 64, 0, nlim);
    });
    const float lt = xhalf_sum(l);
    const float inv = lt > 0.f ? 1.f / lt : 0.f;
    const float sc = g0 * inv;
#pragma unroll
    for (int mt = 0; mt < 2; ++mt)
#pragma unroll
      for (int i = 0; i < 16; ++i) y[mt][i] += sc * o[mt][i];
    const float mbl = (m < -1e29f) ? 0.f : m * L2E;
    kv_loop(tid, sm, kp, 64, vp, 512, 0, ntile, [&](int it, int buf) {
#pragma unroll
      for (int kk = 0; kk < 2; ++kk) {
        f32x16 s;
        qk_scores(lane, sm.k[buf], kk, q, s);
        float pn[16];
#pragma unroll
        for (int i = 0; i < 16; ++i) {
          const int n = it * 64 + kk * 32 + (i & 7) + 8 * half + 16 * (i >> 3);
          const float e = __builtin_amdgcn_exp2f(fmaf(s[i], L2E, -mbl)) * inv;
          pn[i] = (n <= nlim) ? e : 0.f;
        }
#pragma unroll
        for (int j = 0; j < 2; ++j) {
          float v0 = (pn[8 * j] + pn[8 * j + 1]) + (pn[8 * j + 2] + pn[8 * j + 3]);
          float v1 = (pn[8 * j + 4] + pn[8 * j + 5]) + (pn[8 * j + 6] + pn[8 * j + 7]) + pn[8 * j + 3];
          float v2 = pn[8 * j + 7];
          v0 = quad_sum(v0); v1 = quad_sum(v1); v2 = quad_sum(v2);
          if (hh == 0) {
            const int Ja = (it * 64 + kk * 32 + 16 * j + 8 * half) >> 2;
            if (Ja < 128) atomicAdd(&sm.imp[tokl][Ja], v0);
            if (Ja + 1 < 128) atomicAdd(&sm.imp[tokl][Ja + 1], v1);
            if (Ja + 2 < 128) atomicAdd(&sm.imp[tokl][Ja + 2], v2);
          }
        }
      }
    });
  }
  __syncthreads();
  {
    const int tk = w * 8 + (lane >> 3), sub = lane & 7, tt = t0 + tk, jown = tt >> 6;
    unsigned key[16];
#pragma unroll
    for (int i = 0; i < 16; ++i) {
      const int J = i * 8 + sub;
      float v = sm.imp[tk][J];
      if (J == 0 || J == jown) v = 1e4f;
      if (J * 64 > tt) v = NEGF;
      const unsigned u = __float_as_uint(v);
      const unsigned ok = (u & 0x80000000u) ? ~u : (u | 0x80000000u);
      key[i] = (ok & ~127u) | (unsigned)(127 - J);
    }
    unsigned Tk = 0;
    for (int bit = 31; bit >= 0; --bit) {
      const unsigned cand = Tk | (1u << bit);
      int cnt = 0;
#pragma unroll
      for (int i = 0; i < 16; ++i) cnt += (key[i] >= cand) ? 1 : 0;
      cnt = oct_sum(cnt);
      if (cnt >= 16) Tk = cand;
    }
    unsigned wb[4] = {0u, 0u, 0u, 0u};
#pragma unroll
    for (int i = 0; i < 16; ++i) if (key[i] >= Tk) wb[i >> 2] |= 1u << (8 * (i & 3) + sub);
#pragma unroll
    for (int k = 0; k < 4; ++k) wb[k] = oct_or(wb[k]);
    if (sub == 0) { sm.selmask[tk][0] = wb[0]; sm.selmask[tk][1] = wb[1]; sm.selmask[tk][2] = wb[2]; sm.selmask[tk][3] = wb[3]; }
  }
  __syncthreads();
  {
    const int jown = t0 >> 6;
    const bf16_t* kp = (const bf16_t*)(ws + O_KS) + (size_t)b * S * 128 + g * 64;
    const bf16_t* vp = (const bf16_t*)(ws + O_VST) + (size_t)(b * 2 + g) * 64 * S;
    f32x16 o[2];
    zero_o(o);
    float m = NEGF, l = 0.f;
    kv_loop(tid, sm, kp, 128, vp, S, 0, jown, [&](int it, int buf) {
      const bool on = (sm.selmask[tokl][it >> 5] >> (it & 31)) & 1u;
      if (__any(on)) attn_step64<false>(lane, sm.k[buf], sm.vt[buf], q, o, m, l, on, it * 64, 0, t);
    });
    kv_loop(tid, sm, kp, 128, vp, S, jown, jown + 1, [&](int it, int buf) {
      const bool on = (sm.selmask[tokl][it >> 5] >> (it & 31)) & 1u;
      attn_step64<true>(lane, sm.k[buf], sm.vt[buf], q, o, m, l, on, it * 64, 0, t);
    });
    const float lt = xhalf_sum(l);
    const float sc = g1 * (lt > 0.f ? 1.f / lt : 0.f);
#pragma unroll
    for (int mt = 0; mt < 2; ++mt)
#pragma unroll
      for (int i = 0; i < 16; ++i) y[mt][i] += sc * o[mt][i];
  }
  {
    const int tl0 = (t0 - 511) < 0 ? 0 : ((t0 - 511) >> 6);
    const bf16_t* kp = (const bf16_t*)(ws + O_KW) + (size_t)b * S * 128 + g * 64;
    const bf16_t* vp = (const bf16_t*)(ws + O_VWT) + (size_t)(b * 2 + g) * 64 * S;
    f32x16 o[2];
    zero_o(o);
    float m = NEGF, l = 0.f;
    kv_loop(tid, sm, kp, 128, vp, S, tl0, (t0 >> 6) + 1, [&](int it, int buf) {
      attn_step64<true>(lane, sm.k[buf], sm.vt[buf], q, o, m, l, true, it * 64, t - 511, t);
    });
    const float lt = xhalf_sum(l);
    const float sc = g2 * (lt > 0.f ? 1.f / lt : 0.f);
#pragma unroll
    for (int mt = 0; mt < 2; ++mt)
#pragma unroll
      for (int i = 0; i < 16; ++i) y[mt][i] += sc * o[mt][i];
  }
  {
    bf16_t* yp = (bf16_t*)(ws + O_YA) + ((size_t)b * S + t) * 512 + head * 64;
#pragma unroll
    for (int mt = 0; mt < 2; ++mt)
#pragma unroll
      for (int g4 = 0; g4 < 4; ++g4) {
        uint2 u; u.x = pk2(y[mt][4 * g4], y[mt][4 * g4 + 1]); u.y = pk2(y[mt][4 * g4 + 2], y[mt][4 * g4 + 3]);
        *(uint2*)(yp + 32 * mt + 8 * g4 + 4 * half) = u;
      }
  }
}

DI void moba_tile(const Params& p, int rank, char* smem) {
  char* ws = p.ws;
  AttnSmem& sm = *(AttnSmem*)smem;
  const int bh = rank & 15, b = bh >> 3, h = bh & 7, s0 = (63 - (rank >> 4)) * 128, own = s0 >> 8;
  const int tid = otid(), lane = tid & 63, w = tid >> 6, c = lane & 31, half = lane >> 5;
  const int t = s0 + w * 32 + c;
  bf16x8 q[4];
  {
    const bf16_t* qp = (const bf16_t*)(ws + O_QB) + ((size_t)b * S + t) * 512 + h * 64 + half * 8;
#pragma unroll
    for (int ks = 0; ks < 4; ++ks) q[ks] = *(const bf16x8*)(qp + ks * 16);
  }
  unsigned selbits = 0;
  if (own > 0) {
    f32x16 s;
#pragma unroll
    for (int i = 0; i < 16; ++i) s[i] = 0.f;
    const bf16_t* km = (const bf16_t*)(ws + O_KMEAN) + ((size_t)(b * 8 + h) * 32 + c) * 64 + half * 8;
#pragma unroll
    for (int ks = 0; ks < 4; ++ks) { const bf16x8 a = *(const bf16x8*)(km + ks * 16); s = MFMA32(a, q[ks], s); }
    unsigned key[16];
#pragma unroll
    for (int i = 0; i < 16; ++i) {
      const int blk = crow(i, half);
      const unsigned u = __float_as_uint(s[i]);
      const unsigned ok = (u & 0x80000000u) ? ~u : (u | 0x80000000u);
      key[i] = blk < own ? ((ok & ~31u) | (unsigned)(31 - blk)) : 0u;
    }
#pragma unroll
    for (int rnd = 0; rnd < 3; ++rnd) {
      unsigned mx = 0;
#pragma unroll
      for (int i = 0; i < 16; ++i) mx = key[i] > mx ? key[i] : mx;
      const unsigned ox = (unsigned)__shfl_xor((int)mx, 32);
      const unsigned win = mx > ox ? mx : ox;
      if (win != 0u) selbits |= 1u << (31 - (win & 31u));
#pragma unroll
      for (int i = 0; i < 16; ++i) key[i] = (key[i] == win) ? 0u : key[i];
    }
  }
  const bf16_t* kp = (const bf16_t*)(ws + O_KB) + (size_t)b * S * 512 + h * 64;
  const bf16_t* vp = (const bf16_t*)(ws + O_VBT) + (size_t)(b * 8 + h) * 64 * S;
  f32x16 o[2];
  zero_o(o);
  float m = NEGF, l = 0.f;
  const int tq_hi = s0 + w * 32 + 31;
  kv_loop(tid, sm, kp, 512, vp, S, 0, own * 4, [&](int it, int buf) {
    const bool on = (selbits >> (it >> 2)) & 1u;
    if (__any(on)) attn_step64<false>(lane, sm.k[buf], sm.vt[buf], q, o, m, l, on, it * 64, 0, t);
  });
  kv_loop(tid, sm, kp, 512, vp, S, own * 4, ((s0 + 127) >> 6) + 1, [&](int it, int buf) {
    if (it * 64 <= tq_hi) attn_step64<true>(lane, sm.k[buf], sm.vt[buf], q, o, m, l, true, it * 64, 0, t);
  });
  const float lt = xhalf_sum(l);
  const float inv = lt > 0.f ? 1.f / lt : 0.f;
  bf16_t* yp = (bf16_t*)(ws + O_YB) + ((size_t)b * S + t) * 512 + h * 64;
#pragma unroll
  for (int mt = 0; mt < 2; ++mt)
#pragma unroll
    for (int g4 = 0; g4 < 4; ++g4) {
      uint2 u; u.x = pk2(o[mt][4 * g4] * inv, o[mt][4 * g4 + 1] * inv); u.y = pk2(o[mt][4 * g4 + 2] * inv, o[mt][4 * g4 + 3] * inv);
      *(uint2*)(yp + 32 * mt + 8 * g4 + 4 * half) = u;
    }
}


#define XB_TMO      128
#define XB_XCNT(j)  (256  + 64 * (j))
#define XB_XSUB(j)  (1280 + 64 * (j))
#define XB_XGEN(j)  (2304 + 64 * (j))
#define XB_TOP      3328
#define XB_TOPGEN   3392
#define XCD_BAR_WORDS 3456
#define XB_SPIN_CAP (1u << 20)
#define LAS __attribute__((address_space(3)))
DI unsigned xb_ld(unsigned* p)              { return __hip_atomic_load(p, __ATOMIC_RELAXED, __HIP_MEMORY_SCOPE_AGENT); }
DI unsigned xb_add(unsigned* p, unsigned v) { return __hip_atomic_fetch_add(p, v, __ATOMIC_RELAXED, __HIP_MEMORY_SCOPE_AGENT); }
DI unsigned xb_xcc_id() { return (unsigned)__builtin_amdgcn_s_getreg((3 << 11) | 20) & 0xFu; }
#define XB_SPIN(cond, bar) do { unsigned _sp = 0; while (cond) { __builtin_amdgcn_s_sleep(1); \
    if ((++_sp & 255u) == 0u) { if (xb_ld(&(bar)[XB_TMO])) break; if (_sp > XB_SPIN_CAP) { atomicAdd(&(bar)[XB_TMO], 1u); break; } } } } while (0)
struct XcdBarrier { unsigned* bar; unsigned x; volatile LAS unsigned* st; };
DI XcdBarrier xcd_barrier_post(unsigned* bar, volatile LAS unsigned* st) {
  XcdBarrier b; b.bar = bar; b.x = xb_xcc_id(); b.st = st;
  if (threadIdx.x == 0) (void)xb_add(&bar[XB_XCNT(b.x)], 1u);
  return b;
}
DI void xcd_barrier_complete(unsigned* bar, unsigned x, unsigned& nloc, unsigned& nx) {
  const unsigned G = gridDim.x * gridDim.y * gridDim.z;
  unsigned sum, cnt, mine, sp = 0u;
  for (;;) {
    sum = 0u; cnt = 0u; mine = 0u;
#pragma unroll
    for (unsigned j = 0; j < 16; ++j) { const unsigned c = xb_ld(&bar[XB_XCNT(j)]); sum += c; cnt += (c > 0u) ? 1u : 0u; mine = (j == x) ? c : mine; }
    if (sum == G) break;
    __builtin_amdgcn_s_sleep(1);
    if ((++sp & 255u) == 0u) { if (xb_ld(&bar[XB_TMO])) break; if (sp > XB_SPIN_CAP) { atomicAdd(&bar[XB_TMO], 1u); break; } }
  }
  nloc = mine > 0u ? mine : 1u; nx = cnt > 0u ? cnt : 1u;
}
DI void xcd_barrier(const XcdBarrier& b) {
  asm volatile("s_waitcnt vmcnt(0)" ::: "memory");
  __syncthreads();
  if (threadIdx.x == 0) {
    unsigned* bar = b.bar;
    __builtin_amdgcn_s_waitcnt(0);
    unsigned nloc = b.st[0], nx = b.st[1];
    if (nloc == 0u) { xcd_barrier_complete(bar, b.x, nloc, nx); b.st[0] = nloc; b.st[1] = nx; }
    const unsigned old = xb_add(&bar[XB_XSUB(b.x)], 1u);
    const unsigned gen = old / nloc;
    if (old + 1u == (gen + 1u) * nloc) {
      __builtin_amdgcn_fence(__ATOMIC_RELEASE, "agent");
      asm volatile("s_waitcnt vmcnt(0)" ::: "memory");
      const unsigned og = xb_add(&bar[XB_TOP], 1u);
      const unsigned tg = og / nx;
      if (og + 1u == (tg + 1u) * nx) xb_add(&bar[XB_TOPGEN], 1u);
      else XB_SPIN(xb_ld(&bar[XB_TOPGEN]) == tg, bar);
      __builtin_amdgcn_fence(__ATOMIC_ACQUIRE, "agent");
      xb_add(&bar[XB_XGEN(b.x)], 1u);
      asm volatile("s_waitcnt vmcnt(0)" ::: "memory");
    } else {
      XB_SPIN(xb_ld(&bar[XB_XGEN(b.x)]) == gen, bar);
      __builtin_amdgcn_fence(__ATOMIC_ACQUIRE, "agent");
      asm volatile("s_waitcnt vmcnt(0)" ::: "memory");
    }
  }
  __syncthreads();
}

__global__ void __launch_bounds__(256, 2) fwd_megakernel(Params p) {
  __shared__ __attribute__((aligned(16))) char smem[SMEM_BYTES];
  __shared__ uint4 xb_words;
  __shared__ int s_tile;
  char* ws = p.ws;
  if (ws == nullptr) { cg::grid_group grid = cg::this_grid(); grid.sync(); }
  if (threadIdx.x == 0) xb_words = make_uint4(0u, 0u, 0u, 0u);
  __syncthreads();
  const XcdBarrier xb = xcd_barrier_post((unsigned*)(ws + O_BAR), (volatile LAS unsigned*)&xb_words);
  const int G = gridDim.x, bid = blockIdx.x;
  const float* ADA = (const float*)(ws + O_ADA);
  float* X = (float*)(ws + O_X);

  for (int l = 0; l < NL; ++l) {
    if (l == 0) {
      for (int task = bid; task < CONV_TASKS + 384 + 2048; task += G) {
        if (task < CONV_TASKS) conv_task(p, 0, task, smem);
        else if (task < CONV_TASKS + 384) ada_task(p, task - CONV_TASKS, smem);
        else rope_task(p, task - CONV_TASKS - 384);
      }
      xcd_barrier(xb);
    }
    const float* ada_l = ADA + (size_t)l * 2 * 6144;
    const float* xin = (l == 0) ? p.in[0] : X;
    norm_rows(xin, p.in[5] + l * 1024, ada_l + 0, ada_l + 1024, (bf16_t*)(ws + O_H));
    xcd_barrier(xb);
    for (int idx = bid; idx < gemm_slots_big(39); idx += G) { int mt, nt; if (gemm_coords_big(idx, 39, mt, nt)) gemm_in_tile_big(p, l, mt, nt, smem); }
    xcd_barrier(xb);
    for (int task = bid; task < 128 + 256; task += G) {
      if (task < 128) cmp_tile(p, l, task, smem); else kmean_task(p, task - 128, smem);
    }
    xcd_barrier(xb);
    {
      unsigned* qctr = (unsigned*)(ws + O_BAR + 14336) + l * 16;
      for (;;) {
        __syncthreads();
        if (threadIdx.x == 0) s_tile = (int)atomicAdd(qctr, 1u);
        __syncthreads();
        const int rk = s_tile;
        const int nconv = (l + 1 < NL) ? CONV_TASKS : 0;
        if (rk >= 2048 + nconv) break;
        if (rk < 1024) nsa_tile(p, rk, smem);
        else if (rk < 1024 + nconv) conv_task(p, l + 1, rk - 1024, smem);
        else moba_tile(p, rk - 1024 - nconv, smem);
      }
      xcd_barrier(xb);
    }
    for (int idx = bid; idx < gemm_slots_big(8); idx += G) {
      int mt, nt;
      if (gemm_coords_big(idx, 8, mt, nt)) {
        gemm_up_pass_big((const bf16_t*)(ws + O_YA), (const bf16_t*)(ws + wdl(l) + O_WUPA), (const bf16_t*)(ws + O_GBR), 0, (bf16_t*)(ws + O_H), true, mt, nt, smem);
        gemm_up_pass_big((const bf16_t*)(ws + O_YB), (const bf16_t*)(ws + wdl(l) + O_WUPB), (const bf16_t*)(ws + O_GBR), 1024, (bf16_t*)(ws + O_H), false, mt, nt, smem);
      }
    }
    xcd_barrier(xb);
    for (int idx = bid; idx < gemm_slots_big(8); idx += G) {
      int mt, nt;
      if (gemm_coords_big(idx, 8, mt, nt)) gemm_res_tile_big((const bf16_t*)(ws + O_H), 1024, (const bf16_t*)(ws + wdl(l) + O_WOUT), 1024, xin, X, ada_l + 2048, mt, nt, smem);
    }
    xcd_barrier(xb);
    norm_rows(X, p.in[6] + l * 1024, ada_l + 3072, ada_l + 4096, (bf16_t*)(ws + O_H));
    xcd_barrier(xb);
    for (int idx = bid; idx < gemm_slots_big(44); idx += G) { int mt, nt; if (gemm_coords_big(idx, 44, mt, nt)) gemm_ffi_tile_big(p, l, mt, nt, smem); }
    xcd_barrier(xb);
    {
      float* xo = (l == NL - 1) ? p.out : X;
      for (int idx = bid; idx < gemm_slots_big(8); idx += G) {
        int mt, nt;
        if (gemm_coords_big(idx, 8, mt, nt)) gemm_res_tile_big((const bf16_t*)(ws + O_ACT), DFF, (const bf16_t*)(ws + wdl(l) + O_WFFO), DFF, X, xo, ada_l + 5120, mt, nt, smem);
      }
      if (l + 1 < NL) xcd_barrier(xb);
    }
  }
}

extern "C" void kernel_launch(void* const* d_in, const int* in_sizes, int n_in, void* d_out, int out_size,
                              void* d_ws, size_t ws_size, hipStream_t stream) {
  static int grid_blocks = 0;
  if (!grid_blocks) {
    int dev = 0, cus = 0, per_cu = 0;
    (void)hipGetDevice(&dev);
    (void)hipDeviceGetAttribute(&cus, hipDeviceAttributeMultiprocessorCount, dev);
    (void)hipOccupancyMaxActiveBlocksPerMultiprocessor(&per_cu, fwd_megakernel, 256, 0);
    if (per_cu > 2) per_cu = 2;
    if (per_cu < 1) per_cu = 1;
    grid_blocks = cus * per_cu;
    if (ws_size < WS_TOTAL) fprintf(stderr, "kernel_launch: workspace too small: %zu < %zu\n", ws_size, (size_t)WS_TOTAL);
  }
  Params p{};
  for (int i = 0; i < 22; ++i) p.in[i] = (const float*)d_in[i];
  p.out = (float*)d_out;
  p.ws = (char*)d_ws;
  (void)hipMemsetAsync((char*)d_ws + O_BAR, 0, 16384, stream);
  void* args[] = {&p};
  hipError_t e = hipLaunchCooperativeKernel((void*)fwd_megakernel, dim3(grid_blocks), dim3(256), args, 0, stream);
  if (e != hipSuccess) fprintf(stderr, "cooperative launch failed: %s (grid %d)\n", hipGetErrorString(e), grid_blocks);
}
```

```cpp
#include <hip/hip_runtime.h>
#include <hip/hip_cooperative_groups.h>
#include <cstdio>
#include <cstdint>
namespace cg = cooperative_groups;

typedef unsigned short bf16_t;
typedef short bf16x8 __attribute__((ext_vector_type(8)));
typedef float f32x16 __attribute__((ext_vector_type(16)));
typedef float f32x2 __attribute__((ext_vector_type(2)));
typedef __bf16 bf2_t __attribute__((ext_vector_type(2)));
typedef unsigned u32x4 __attribute__((ext_vector_type(4)));
#define DI __device__ __forceinline__
#define MFMA32(a, b, c) __builtin_amdgcn_mfma_f32_32x32x16_bf16((a), (b), (c), 0, 0, 0)

constexpr int NB = 2, S = 8192, D = 1024, NL = 4, T = NB * S;
constexpr int NIN = 4888, NPIN = 4992, DFF = 2816, NFFI = 5632;
constexpr float L2E = 1.4426950408889634f;
constexpr float NEGF = -1e30f;

constexpr size_t O_WIN = 0;
constexpr size_t O_WUPA = O_WIN + (size_t)NPIN * 1024 * 2;
constexpr size_t O_WUPB = O_WUPA + (size_t)1024 * 512 * 2;
constexpr size_t O_WOUT = O_WUPB + (size_t)1024 * 512 * 2;
constexpr size_t O_WFFI = O_WOUT + (size_t)1024 * 1024 * 2;
constexpr size_t O_WFFO = O_WFFI + (size_t)NFFI * 1024 * 2;
constexpr size_t O_CKW1 = O_WFFO + (size_t)1024 * DFF * 2;
constexpr size_t O_CVW1 = O_CKW1 + (size_t)128 * 2048 * 2;
constexpr size_t O_CKW2 = O_CVW1 + (size_t)128 * 2048 * 2;
constexpr size_t O_CVW2 = O_CKW2 + (size_t)64 * 128 * 2;
constexpr size_t O_ADA = O_CVW2 + (size_t)64 * 128 * 2;
constexpr size_t O_COS = O_ADA + (size_t)NL * NB * 6144 * 4;
constexpr size_t O_SIN = O_COS + (size_t)T * 32 * 4;
constexpr size_t O_X = O_SIN + (size_t)T * 32 * 4;
constexpr size_t O_H = O_X + (size_t)T * 1024 * 4;
constexpr size_t O_QA = O_H + (size_t)T * 1024 * 2;
constexpr size_t O_KC = O_QA + (size_t)T * 512 * 2;
constexpr size_t O_VC = O_KC + (size_t)T * 128 * 2;
constexpr size_t O_KS = O_VC + (size_t)T * 128 * 2;
constexpr size_t O_KW = O_KS + (size_t)T * 128 * 2;
constexpr size_t O_VST = O_KW + (size_t)T * 128 * 2;
constexpr size_t O_VWT = O_VST + (size_t)T * 128 * 2;
constexpr size_t O_QB = O_VWT + (size_t)T * 128 * 2;
constexpr size_t O_KB = O_QB + (size_t)T * 512 * 2;
constexpr size_t O_VBT = O_KB + (size_t)T * 512 * 2;
constexpr size_t O_GBR = O_VBT + (size_t)T * 512 * 2;
constexpr size_t O_GA = O_GBR + (size_t)T * 2048 * 2;
constexpr size_t O_KCMP = O_GA + (size_t)T * 24 * 4;
constexpr size_t O_VCMPT = O_KCMP + (size_t)NB * 2 * 512 * 64 * 2;
constexpr size_t O_KMEAN = O_VCMPT + (size_t)NB * 2 * 512 * 64 * 2;
constexpr size_t O_YA = O_KMEAN + (size_t)NB * 8 * 32 * 64 * 2;
constexpr size_t O_YB = O_YA + (size_t)T * 512 * 2;
constexpr size_t WS_END = O_YB + (size_t)T * 512 * 2;
constexpr size_t O_BAR = WS_END;
constexpr size_t O_W2 = O_BAR + 16384;
constexpr size_t WSZ = O_ADA - O_WIN;
constexpr size_t WS_TOTAL = O_W2 + WSZ;
__host__ __device__ constexpr size_t wdl(int l) { return (l & 1) ? (O_W2 - O_WIN) : 0; }
constexpr size_t O_ACT = O_QA;
static_assert((size_t)T * DFF * 2 <= O_GA - O_QA, "ACT alias");

struct Params {
  const float* in[22];
  float* out;
  char* ws;
};

constexpr int SMEM_BYTES = 73728;

DI float xhalf_max(float v) { auto r = __builtin_amdgcn_permlane32_swap(__float_as_uint(v), __float_as_uint(v), false, false); return fmaxf(__uint_as_float(r[0]), __uint_as_float(r[1])); }
DI float xhalf_sum(float v) { auto r = __builtin_amdgcn_permlane32_swap(__float_as_uint(v), __float_as_uint(v), false, false); return __uint_as_float(r[0]) + __uint_as_float(r[1]); }
template <int CTRL> DI unsigned dpp_u(unsigned v) { return (unsigned)__builtin_amdgcn_update_dpp(0, (int)v, CTRL, 0xf, 0xf, true); }
DI float quad_sum(float v) { v += __uint_as_float(dpp_u<0xB1>(__float_as_uint(v))); v += __uint_as_float(dpp_u<0x4E>(__float_as_uint(v))); return v; }
DI int oct_sum(int v) { v += (int)dpp_u<0xB1>((unsigned)v); v += (int)dpp_u<0x4E>((unsigned)v); v += (int)dpp_u<0x141>((unsigned)v); return v; }
DI unsigned oct_or(unsigned v) { v |= dpp_u<0xB1>(v); v |= dpp_u<0x4E>(v); v |= dpp_u<0x141>(v); return v; }
DI int otid() { int t = threadIdx.x; asm volatile("" : "+v"(t)); return t; }
DI unsigned pk2(float a, float b) { f32x2 v = {a, b}; bf2_t r = __builtin_convertvector(v, bf2_t); return __builtin_bit_cast(unsigned, r); }
DI float bf_lo(unsigned u) { return __uint_as_float(u << 16); }
DI float bf_hi(unsigned u) { return __uint_as_float(u & 0xffff0000u); }
DI float bf2f(bf16_t h) { return __uint_as_float(((unsigned)h) << 16); }
DI int crow(int i, int h) { return (i & 3) + 8 * (i >> 2) + 4 * h; }
DI float sigmoidf_(float x) { return 1.f / (1.f + __expf(-x)); }
DI uint4 pack8(const float* v) { uint4 r; r.x = pk2(v[0], v[1]); r.y = pk2(v[2], v[3]); r.z = pk2(v[4], v[5]); r.w = pk2(v[6], v[7]); return r; }

DI int map_in(int n) {
  if (n < 1280) return n;
  if (n < 4864) return n + 24;
  if (n < 4888) return n - 4864 + 1280;
  return -1;
}
DI int map_ffi(int n) {
  const int tile = n >> 7, within = n & 127, wn = within >> 6, sub = within & 63, isup = sub >> 5, c = sub & 31;
  return (isup ? DFF : 0) + tile * 64 + wn * 32 + c;
}

template <int KT>
DI void conv_tile(const float* __restrict__ src, int srcN, int K, bf16_t* __restrict__ dst, int mode, int nt, int kg, char* smem) {
  float (*st)[65] = (float (*)[65])smem;
  const int tid = otid(), j = tid & 63, i0 = tid >> 6;
  const int n0 = nt * 64, k0 = kg * 64 * KT;
  int ns = n0 + j;
  if (mode == 1) ns = map_in(ns); else if (mode == 2) ns = map_ffi(ns);
  float v[KT * 16];
#pragma unroll
  for (int ii = 0; ii < KT * 16; ++ii) {
    const int k = i0 + 4 * ii;
    v[ii] = ns >= 0 ? src[(size_t)(k0 + k) * srcN + ns] : 0.f;
  }
#pragma unroll
  for (int ii = 0; ii < KT * 16; ++ii) st[i0 + 4 * ii][j] = v[ii];
  __syncthreads();
  const int nrow = tid >> 2, kc = (tid & 3) * 16;
#pragma unroll
  for (int sub = 0; sub < KT; ++sub) {
    float o[16];
#pragma unroll
    for (int q = 0; q < 16; ++q) o[q] = st[sub * 64 + kc + q][nrow];
    uint4* dp = (uint4*)(dst + (size_t)(n0 + nrow) * K + k0 + sub * 64 + kc);
    dp[0] = pack8(o);
    dp[1] = pack8(o + 8);
  }
  __syncthreads();
}

constexpr int CONV_TASKS = 78 * 4 + 32 + 32 + 64 + 88 * 4 + 16 * 11 + 16 + 16 + 1 + 1;

DI void conv_task(const Params& p, int l, int task, char* smem) {
  char* ws = p.ws + wdl(l);
  int t = task;
  if (t < 78 * 4) { conv_tile<4>(p.in[7] + (size_t)l * 1024 * NIN, NIN, 1024, (bf16_t*)(ws + O_WIN), 1, t % 78, t / 78, smem); return; }
  t -= 78 * 4;
  if (t < 32) { conv_tile<4>(p.in[17] + (size_t)l * 512 * 1024, 1024, 512, (bf16_t*)(ws + O_WUPA), 0, t % 16, t / 16, smem); return; }
  t -= 32;
  if (t < 32) { conv_tile<4>(p.in[18] + (size_t)l * 512 * 1024, 1024, 512, (bf16_t*)(ws + O_WUPB), 0, t % 16, t / 16, smem); return; }
  t -= 32;
  if (t < 64) { conv_tile<4>(p.in[19] + (size_t)l * 1024 * 1024, 1024, 1024, (bf16_t*)(ws + O_WOUT), 0, t % 16, t / 16, smem); return; }
  t -= 64;
  if (t < 88 * 4) { conv_tile<4>(p.in[20] + (size_t)l * 1024 * NFFI, NFFI, 1024, (bf16_t*)(ws + O_WFFI), 2, t % 88, t / 88, smem); return; }
  t -= 88 * 4;
  if (t < 16 * 11) { conv_tile<4>(p.in[21] + (size_t)l * DFF * 1024, 1024, DFF, (bf16_t*)(ws + O_WFFO), 0, t % 16, t / 16, smem); return; }
  t -= 16 * 11;
  if (t < 16) { conv_tile<4>(p.in[11] + (size_t)l * 2048 * 128, 128, 2048, (bf16_t*)(ws + O_CKW1), 0, t % 2, t / 2, smem); return; }
  t -= 16;
  if (t < 16) { conv_tile<4>(p.in[13] + (size_t)l * 2048 * 128, 128, 2048, (bf16_t*)(ws + O_CVW1), 0, t % 2, t / 2, smem); return; }
  t -= 16;
  if (t < 1) { conv_tile<2>(p.in[12] + (size_t)l * 128 * 64, 64, 128, (bf16_t*)(ws + O_CKW2), 0, 0, 0, smem); return; }
  conv_tile<2>(p.in[14] + (size_t)l * 128 * 64, 64, 128, (bf16_t*)(ws + O_CVW2), 0, 0, 0, smem);
}

DI void ada_task(const Params& p, int task, char* smem) {
  float* sc = (float*)smem;
  float* red = sc + 2048;
  const int tid = otid(), l = task / 96, n0 = (task % 96) * 64;
  for (int i = tid; i < 2048; i += 256) { const float c = p.in[1][i]; sc[i] = c / (1.f + __expf(-c)); }
  __syncthreads();
  const int j = tid & 63, kq = tid >> 6;
  const float* w = p.in[3] + ((size_t)l * 1024 + kq * 256) * 6144 + n0 + j;
  float a0 = 0.f, a1 = 0.f;
#pragma unroll 8
  for (int k = 0; k < 256; ++k) { const float wv = w[(size_t)k * 6144]; a0 += sc[kq * 256 + k] * wv; a1 += sc[1024 + kq * 256 + k] * wv; }
  red[(kq * 2 + 0) * 64 + j] = a0; red[(kq * 2 + 1) * 64 + j] = a1;
  __syncthreads();
  if (tid < 128) {
    const int b = tid >> 6;
    float s = red[(0 * 2 + b) * 64 + j] + red[(1 * 2 + b) * 64 + j] + red[(2 * 2 + b) * 64 + j] + red[(3 * 2 + b) * 64 + j];
    ((float*)(p.ws + O_ADA))[((size_t)l * 2 + b) * 6144 + n0 + j] = s + p.in[4][(size_t)l * 6144 + n0 + j];
  }
  __syncthreads();
}

DI void rope_task(const Params& p, int task) {
  const int tid = otid(), row = task * 8 + (tid >> 5), i = tid & 31;
  const int pos = ((const int*)p.in[2])[row];
  const float inv = 1.0f / powf(10000.0f, (float)(2 * i) / 64.0f);
  const float ang = (float)pos * inv;
  ((float*)(p.ws + O_COS))[(size_t)row * 32 + i] = cosf(ang);
  ((float*)(p.ws + O_SIN))[(size_t)row * 32 + i] = sinf(ang);
}

DI void norm_rows(const float* __restrict__ xin, const float* __restrict__ gn, const float* __restrict__ ada_sh, const float* __restrict__ ada_sc,
                  bf16_t* __restrict__ H) {
  const int tid_ = otid(), lane = tid_ & 63, w = tid_ >> 6;
  const int nw = gridDim.x * 4;
  for (int row0 = (blockIdx.x * 4 + w) * 8; row0 < T; row0 += nw * 8) {
    const int b = row0 / S;
    float4 v[8][4];
#pragma unroll
    for (int r = 0; r < 8; ++r)
#pragma unroll
      for (int i = 0; i < 4; ++i) v[r][i] = *(const float4*)(xin + (size_t)(row0 + r) * 1024 + (lane + 64 * i) * 4);
    float4 gk[4], sh[4];
#pragma unroll
    for (int i = 0; i < 4; ++i) {
      const int col = (lane + 64 * i) * 4;
      const float4 g = *(const float4*)(gn + col);
      const float4 sc = *(const float4*)(ada_sc + (size_t)b * 6144 + col);
      sh[i] = *(const float4*)(ada_sh + (size_t)b * 6144 + col);
      gk[i].x = g.x * (1.f + sc.x); gk[i].y = g.y * (1.f + sc.y); gk[i].z = g.z * (1.f + sc.z); gk[i].w = g.w * (1.f + sc.w);
    }
    float ss[8];
#pragma unroll
    for (int r = 0; r < 8; ++r) {
      ss[r] = 0.f;
#pragma unroll
      for (int i = 0; i < 4; ++i) ss[r] += v[r][i].x * v[r][i].x + v[r][i].y * v[r][i].y + v[r][i].z * v[r][i].z + v[r][i].w * v[r][i].w;
    }
#pragma unroll
    for (int o = 32; o >= 1; o >>= 1) {
#pragma unroll
      for (int r = 0; r < 8; ++r) ss[r] += __shfl_xor(ss[r], o);
    }
#pragma unroll
    for (int r = 0; r < 8; ++r) {
      const float rr = rsqrtf(ss[r] * (1.f / 1024.f) + 1e-6f);
#pragma unroll
      for (int i = 0; i < 4; ++i) {
        const int col = (lane + 64 * i) * 4;
        uint2 o;
        o.x = pk2(v[r][i].x * rr * gk[i].x + sh[i].x, v[r][i].y * rr * gk[i].y + sh[i].y);
        o.y = pk2(v[r][i].z * rr * gk[i].z + sh[i].z, v[r][i].w * rr * gk[i].w + sh[i].w);
        *(uint2*)(H + (size_t)(row0 + r) * 1024 + col) = o;
      }
    }
  }
}

DI void qk_epilogue(const float* st  , int m0, const float* __restrict__ gain, float scale, bf16_t* __restrict__ dst, int dstride, int dcol0,
                    const float* __restrict__ COS, const float* __restrict__ SIN) {
  const int tid = otid(), row = tid & 127, hd = tid >> 7;
  const float* sp = st + row * 132 + hd * 64;
  float ss = 0.f;
#pragma unroll 4
  for (int j = 0; j < 64; j += 4) { const float4 v = *(const float4*)(sp + j); ss += v.x * v.x + v.y * v.y + v.z * v.z + v.w * v.w; }
  const float rr = rsqrtf(ss * (1.f / 64.f) + 1e-6f);
  const size_t tok = (size_t)(m0 + row);
  bf16_t* dp = dst + tok * dstride + dcol0 + hd * 64;
#pragma unroll 1
  for (int j = 0; j < 32; j += 8) {
    float o1[8], o2[8];
#pragma unroll
    for (int q = 0; q < 8; ++q) {
      const float x1 = sp[j + q] * rr * gain[j + q], x2 = sp[j + q + 32] * rr * gain[j + q + 32];
      const float cs = COS[tok * 32 + j + q], sn = SIN[tok * 32 + j + q];
      o1[q] = (x1 * cs - x2 * sn) * scale;
      o2[q] = (x2 * cs + x1 * sn) * scale;
    }
    *(uint4*)(dp + j) = pack8(o1);
    *(uint4*)(dp + j + 32) = pack8(o2);
  }
}
DI void raw_epilogue(const float* st, int m0, bf16_t* __restrict__ dst, int dstride, int dcol0, bool sig) {
  const int tid = otid(), row = tid & 127, hd = tid >> 7;
  const float* sp = st + row * 132 + hd * 64;
  bf16_t* dp = dst + (size_t)(m0 + row) * dstride + dcol0 + hd * 64;
#pragma unroll 2
  for (int j = 0; j < 64; j += 8) {
    float o[8];
#pragma unroll
    for (int q = 0; q < 8; ++q) { const float v = sp[j + q]; o[q] = sig ? sigmoidf_(v) : v; }
    *(uint4*)(dp + j) = pack8(o);
  }
}
DI void vt_epilogue(const float* st, int m0, bf16_t* __restrict__ dst, int nheads, int head0) {
  const int tid = otid(), col = tid & 127, rh = tid >> 7;
  const int b = m0 / S, s0 = m0 % S, hd = head0 + (col >> 6), d = col & 63;
  bf16_t* dp = dst + ((size_t)(b * nheads + hd) * 64 + d) * S + s0 + rh * 64;
#pragma unroll 2
  for (int r8 = 0; r8 < 8; ++r8) {
    float o[8];
#pragma unroll
    for (int q = 0; q < 8; ++q) o[q] = st[(rh * 64 + r8 * 8 + q) * 132 + col];
    *(uint4*)(dp + r8 * 8) = pack8(o);
  }
}


DI void gemm_mainloop_big(const bf16_t* __restrict__ A, int lda, const bf16_t* __restrict__ Bt, int ldb, int K, int m0, int n0,
                          f32x16 (&acc)[4][2], char* smem) {
  bf16_t (*sa)[72] = (bf16_t (*)[72])smem;
  bf16_t (*sb)[72] = (bf16_t (*)[72])(smem + 256 * 72 * 2);
  const int tid = otid(), lane = tid & 63, w = tid >> 6, wm = w >> 1, wn = w & 1;
  const int r = lane & 31, half = lane >> 5;
  const int nk = K >> 6;
  u32x4 ra[8], rb[4];
  const bf16_t* ap = A + (size_t)(m0 + (tid >> 3)) * lda + (tid & 7) * 8;
  const bf16_t* bp = Bt + (size_t)(n0 + (tid >> 3)) * ldb + (tid & 7) * 8;
#pragma unroll
  for (int i = 0; i < 8; ++i) ra[i] = *(const u32x4*)(ap + (size_t)(32 * i) * lda);
#pragma unroll
  for (int i = 0; i < 4; ++i) rb[i] = *(const u32x4*)(bp + (size_t)(32 * i) * ldb);
  __syncthreads();
#pragma unroll
  for (int i = 0; i < 8; ++i) *(u32x4*)&sa[(tid >> 3) + 32 * i][(tid & 7) * 8] = ra[i];
#pragma unroll
  for (int i = 0; i < 4; ++i) *(u32x4*)&sb[(tid >> 3) + 32 * i][(tid & 7) * 8] = rb[i];
  __syncthreads();
  for (int kt = 0; kt < nk; ++kt) {
    if (kt + 1 < nk) {
#pragma unroll
      for (int i = 0; i < 8; ++i) ra[i] = *(const u32x4*)(ap + (size_t)(32 * i) * lda + (kt + 1) * 64);
#pragma unroll
      for (int i = 0; i < 4; ++i) rb[i] = *(const u32x4*)(bp + (size_t)(32 * i) * ldb + (kt + 1) * 64);
    }
#pragma unroll
    for (int ks = 0; ks < 4; ++ks) {
      bf16x8 af[4], bfr[2];
#pragma unroll
      for (int f = 0; f < 4; ++f) af[f] = *(const bf16x8*)&sa[wm * 128 + f * 32 + r][ks * 16 + half * 8];
#pragma unroll
      for (int f = 0; f < 2; ++f) bfr[f] = *(const bf16x8*)&sb[wn * 64 + f * 32 + r][ks * 16 + half * 8];
#pragma unroll
      for (int mf = 0; mf < 4; ++mf)
#pragma unroll
        for (int nf = 0; nf < 2; ++nf) acc[mf][nf] = MFMA32(af[mf], bfr[nf], acc[mf][nf]);
    }
    __syncthreads();
    if (kt + 1 < nk) {
#pragma unroll
      for (int i = 0; i < 8; ++i) *(u32x4*)&sa[(tid >> 3) + 32 * i][(tid & 7) * 8] = ra[i];
#pragma unroll
      for (int i = 0; i < 4; ++i) *(u32x4*)&sb[(tid >> 3) + 32 * i][(tid & 7) * 8] = rb[i];
    }
    __syncthreads();
  }
}
DI void zero_acc_big(f32x16 (&acc)[4][2]) {
#pragma unroll
  for (int a = 0; a < 4; ++a)
#pragma unroll
    for (int b = 0; b < 2; ++b)
#pragma unroll
      for (int i = 0; i < 16; ++i) acc[a][b][i] = 0.f;
}
DI void stage_half(float* st, const f32x16 (&acc)[4][2], int h, int tid) {
  const int lane = tid & 63, w = tid >> 6, wm = w >> 1, wn = w & 1, c = lane & 31, half = lane >> 5;
  if (wm == h) {
#pragma unroll
    for (int mf = 0; mf < 4; ++mf)
#pragma unroll
      for (int nf = 0; nf < 2; ++nf)
#pragma unroll
        for (int i = 0; i < 16; ++i) st[(mf * 32 + crow(i, half)) * 132 + wn * 64 + nf * 32 + c] = acc[mf][nf][i];
  }
}
DI bool gemm_coords_big(int idx, int NT, int& mt, int& nt) {
  const int x = idx & 7, q = idx >> 3, om = q >> 6, qq = q & 63;
  const int macro = om * 8 + x, Mb = macro & 7, Nb = macro >> 3;
  mt = Mb * 8 + (qq & 7); nt = Nb * 8 + (qq >> 3);
  return nt < NT;
}
DI int gemm_slots_big(int NT) { return 8 * ((NT + 7) / 8) * 64; }

DI void in_epilogue_half(const Params& p, int l, const float* st, int m0, int nt) {
  char* ws = p.ws;
  const float* COS = (const float*)(ws + O_COS);
  const float* SIN = (const float*)(ws + O_SIN);
  if (nt < 4) qk_epilogue(st, m0, p.in[8] + l * 64, 0.125f, (bf16_t*)(ws + O_QA), 512, nt * 128, COS, SIN);
  else if (nt == 4) raw_epilogue(st, m0, (bf16_t*)(ws + O_KC), 128, 0, false);
  else if (nt == 5) raw_epilogue(st, m0, (bf16_t*)(ws + O_VC), 128, 0, false);
  else if (nt == 6) qk_epilogue(st, m0, p.in[9] + l * 64, 1.f, (bf16_t*)(ws + O_KS), 128, 0, COS, SIN);
  else if (nt == 7) vt_epilogue(st, m0, (bf16_t*)(ws + O_VST), 2, 0);
  else if (nt == 8) qk_epilogue(st, m0, p.in[9] + l * 64, 1.f, (bf16_t*)(ws + O_KW), 128, 0, COS, SIN);
  else if (nt == 9) vt_epilogue(st, m0, (bf16_t*)(ws + O_VWT), 2, 0);
  else if (nt < 14) qk_epilogue(st, m0, p.in[15] + l * 64, 0.125f, (bf16_t*)(ws + O_QB), 512, (nt - 10) * 128, COS, SIN);
  else if (nt < 18) qk_epilogue(st, m0, p.in[16] + l * 64, 1.f, (bf16_t*)(ws + O_KB), 512, (nt - 14) * 128, COS, SIN);
  else if (nt < 22) vt_epilogue(st, m0, (bf16_t*)(ws + O_VBT), 8, (nt - 18) * 2);
  else if (nt < 38) raw_epilogue(st, m0, (bf16_t*)(ws + O_GBR), 2048, (nt - 22) * 128, true);
  else {
    const int tid = otid();
    if (tid < 128) {
      float* gp = (float*)(ws + O_GA) + (size_t)(m0 + tid) * 24;
#pragma unroll
      for (int j = 0; j < 24; ++j) gp[j] = sigmoidf_(st[tid * 132 + j]);
    }
  }
}
DI void gemm_in_tile_big(const Params& p, int l, int mt, int nt, char* smem) {
  char* ws = p.ws;
  f32x16 acc[4][2];
  zero_acc_big(acc);
  const int m0 = mt * 256, n0 = nt * 128;
  gemm_mainloop_big((const bf16_t*)(ws + O_H), 1024, (const bf16_t*)(ws + wdl(l) + O_WIN), 1024, 1024, m0, n0, acc, smem);
  float* st = (float*)smem;
#pragma unroll
  for (int h = 0; h < 2; ++h) {
    stage_half(st, acc, h, otid());
    __syncthreads();
    in_epilogue_half(p, l, st, m0 + h * 128, nt);
    __syncthreads();
  }
}
DI void gemm_res_tile_big(const bf16_t* A, int lda, const bf16_t* Bt, int K, const float* __restrict__ xin, float* __restrict__ xout,
                          const float* __restrict__ gate, int mt, int nt, char* smem) {
  const int m0 = mt * 256, n0 = nt * 128;
  f32x16 acc[4][2];
  zero_acc_big(acc);
  gemm_mainloop_big(A, lda, Bt, K, K, m0, n0, acc, smem);
  float* st = (float*)smem;
  const int b = m0 / S;
#pragma unroll
  for (int h = 0; h < 2; ++h) {
    const int tid = otid();
    stage_half(st, acc, h, tid);
    __syncthreads();
    const int r = tid >> 5, ch = tid & 31;
    const float4 g = *(const float4*)(gate + (size_t)b * 6144 + n0 + ch * 4);
#pragma unroll 4
    for (int ps = 0; ps < 16; ++ps) {
      const int row = ps * 8 + r;
      const float4 a = *(const float4*)(st + row * 132 + ch * 4);
      const size_t off = (size_t)(m0 + h * 128 + row) * 1024 + n0 + ch * 4;
      const float4 xi = *(const float4*)(xin + off);
      float4 o; o.x = xi.x + g.x * a.x; o.y = xi.y + g.y * a.y; o.z = xi.z + g.z * a.z; o.w = xi.w + g.w * a.w;
      *(float4*)(xout + off) = o;
    }
    __syncthreads();
  }
}
DI void gemm_ffi_tile_big(const Params& p, int l, int mt, int nt, char* smem) {
  char* ws = p.ws;
  const int m0 = mt * 256, n0 = nt * 128;
  f32x16 acc[4][2];
  zero_acc_big(acc);
  gemm_mainloop_big((const bf16_t*)(ws + O_H), 1024, (const bf16_t*)(ws + wdl(l) + O_WFFI), 1024, 1024, m0, n0, acc, smem);
  bf16_t* ACT = (bf16_t*)(ws + O_ACT);
  bf16_t (*sbt)[72] = (bf16_t (*)[72])smem;
  const int tid = otid(), lane = tid & 63, w = tid >> 6, wm = w >> 1, wn = w & 1, c = lane & 31, half = lane >> 5;
#pragma unroll
  for (int mf = 0; mf < 4; ++mf)
#pragma unroll
    for (int i = 0; i < 16; ++i) {
      const float g = acc[mf][0][i], u = acc[mf][1][i];
      const float a = g / (1.f + __expf(-g)) * u;
      sbt[wm * 128 + mf * 32 + crow(i, half)][wn * 32 + c] = (bf16_t)(pk2(a, 0.f) & 0xffff);
    }
  __syncthreads();
  const int r = tid >> 3, ch = tid & 7;
#pragma unroll
  for (int ps = 0; ps < 8; ++ps) {
    const int row = ps * 32 + r;
    *(u32x4*)(ACT + (size_t)(m0 + row) * DFF + nt * 64 + ch * 8) = *(const u32x4*)&sbt[row][ch * 8];
  }
  __syncthreads();
}
DI void gemm_up_pass_big(const bf16_t* Y, const bf16_t* W, const bf16_t* __restrict__ GBR, int gcol0, bf16_t* __restrict__ MG, bool first,
                         int mt, int nt, char* smem) {
  const int m0 = mt * 256, n0 = nt * 128;
  f32x16 acc[4][2];
  zero_acc_big(acc);
  gemm_mainloop_big(Y, 512, W, 512, 512, m0, n0, acc, smem);
  float* st = (float*)smem;
#pragma unroll
  for (int h = 0; h < 2; ++h) {
    const int tid = otid();
    stage_half(st, acc, h, tid);
    __syncthreads();
    const int r = tid >> 4, ch = tid & 15;
#pragma unroll 2
    for (int ps = 0; ps < 8; ++ps) {
      const int row = ps * 16 + r;
      const float4 a0 = *(const float4*)(st + row * 132 + ch * 8), a1 = *(const float4*)(st + row * 132 + ch * 8 + 4);
      const size_t grow = (size_t)(m0 + h * 128 + row);
      const u32x4 gv = *(const u32x4*)(GBR + grow * 2048 + gcol0 + n0 + ch * 8);
      float v[8];
      v[0] = bf_lo(gv.x) * a0.x; v[1] = bf_hi(gv.x) * a0.y; v[2] = bf_lo(gv.y) * a0.z; v[3] = bf_hi(gv.y) * a0.w;
      v[4] = bf_lo(gv.z) * a1.x; v[5] = bf_hi(gv.z) * a1.y; v[6] = bf_lo(gv.w) * a1.z; v[7] = bf_hi(gv.w) * a1.w;
      bf16_t* mp = MG + grow * 1024 + n0 + ch * 8;
      if (!first) {
        const u32x4 pv = *(const u32x4*)mp;
        v[0] += bf_lo(pv.x); v[1] += bf_hi(pv.x); v[2] += bf_lo(pv.y); v[3] += bf_hi(pv.y);
        v[4] += bf_lo(pv.z); v[5] += bf_hi(pv.z); v[6] += bf_lo(pv.w); v[7] += bf_hi(pv.w);
      }
      u32x4 ov; ov.x = pk2(v[0], v[1]); ov.y = pk2(v[2], v[3]); ov.z = pk2(v[4], v[5]); ov.w = pk2(v[6], v[7]);
      *(u32x4*)mp = ov;
    }
    __syncthreads();
  }
}

DI float gelu_tanh(float x) {
  const float u = 0.7978845608028654f * (x + 0.044715f * x * x * x);
  const float e = __expf(2.f * u);
  const float th = 1.f - 2.f / (e + 1.f);
  return 0.5f * x * (1.f + th);
}

DI void cmp_tile(const Params& p, int l, int tile, char* smem) {
  char* ws = p.ws;
  const int kv = tile & 1, bg = (tile >> 1) & 3, nb = tile >> 3, b = bg >> 1, g = bg & 1;
  const int tid = otid(), lane = tid & 63, w = tid >> 6, r = lane & 31, half = lane >> 5;
  const bf16_t* src = (const bf16_t*)(ws + (kv ? O_VC : O_KC));
  const bf16_t* W1T = (const bf16_t*)(ws + wdl(l) + (kv ? O_CVW1 : O_CKW1));
  const bf16_t* W2T = (const bf16_t*)(ws + wdl(l) + (kv ? O_CVW2 : O_CKW2));
  const float* pe = p.in[10] + (size_t)l * 32 * 64;
  bf16_t (*hid)[136] = (bf16_t (*)[136])smem;
  float (*outf)[68] = (float (*)[68])(smem + 8704);
  int n = nb * 32 + r; if (n > 510) n = 510;
  const bf16_t* arow = src + ((size_t)b * S + 16 * n) * 128 + g * 64 + half * 8;
  float (*part)[32][128] = (float (*)[32][128])smem;
  f32x16 acc[4];
#pragma unroll
  for (int nf = 0; nf < 4; ++nf)
#pragma unroll
    for (int i = 0; i < 16; ++i) acc[nf][i] = 0.f;
  const bf16_t* brow = W1T + (size_t)r * 2048 + half * 8;
#pragma unroll 2
  for (int t8 = 0; t8 < 8; ++t8) {
    const int tl = 8 * w + t8;
#pragma unroll
    for (int dk = 0; dk < 4; ++dk) {
      const uint4 av = *(const uint4*)(arow + (size_t)tl * 128 + dk * 16);
      const float4 p0 = *(const float4*)(pe + tl * 64 + dk * 16 + half * 8);
      const float4 p1 = *(const float4*)(pe + tl * 64 + dk * 16 + half * 8 + 4);
      uint4 a2;
      a2.x = pk2(bf_lo(av.x) + p0.x, bf_hi(av.x) + p0.y);
      a2.y = pk2(bf_lo(av.y) + p0.z, bf_hi(av.y) + p0.w);
      a2.z = pk2(bf_lo(av.z) + p1.x, bf_hi(av.z) + p1.y);
      a2.w = pk2(bf_lo(av.w) + p1.z, bf_hi(av.w) + p1.w);
      const bf16x8 a8 = __builtin_bit_cast(bf16x8, a2);
#pragma unroll
      for (int nf = 0; nf < 4; ++nf) {
        const bf16x8 bv = *(const bf16x8*)(brow + (size_t)(nf * 32) * 2048 + tl * 64 + dk * 16);
        acc[nf] = MFMA32(a8, bv, acc[nf]);
      }
    }
  }
  __syncthreads();
#pragma unroll
  for (int nf = 0; nf < 4; ++nf)
#pragma unroll
    for (int i = 0; i < 16; ++i) part[w][crow(i, half)][nf * 32 + r] = acc[nf][i];
  __syncthreads();
  float hv[16];
#pragma unroll
  for (int e = 0; e < 16; ++e) {
    const int idx = tid + 256 * e, row = idx >> 7, col = idx & 127;
    hv[e] = gelu_tanh((part[0][row][col] + part[1][row][col]) + (part[2][row][col] + part[3][row][col]));
  }
  __syncthreads();
#pragma unroll
  for (int e = 0; e < 16; ++e) {
    const int idx = tid + 256 * e, row = idx >> 7, col = idx & 127;
    hid[row][col] = (bf16_t)(pk2(hv[e], 0.f) & 0xffff);
  }
  __syncthreads();
  if (w < 2) {
    f32x16 a2;
#pragma unroll
    for (int i = 0; i < 16; ++i) a2[i] = 0.f;
#pragma unroll
    for (int ks = 0; ks < 8; ++ks) {
      const bf16x8 av = *(const bf16x8*)&hid[r][ks * 16 + half * 8];
      const bf16x8 bv = *(const bf16x8*)(W2T + (size_t)(32 * w + r) * 128 + ks * 16 + half * 8);
      a2 = MFMA32(av, bv, a2);
    }
#pragma unroll
    for (int i = 0; i < 16; ++i) outf[crow(i, half)][32 * w + r] = a2[i];
  }
  __syncthreads();
  if (kv == 0) {
    const int row = tid >> 3, part = tid & 7, nn = nb * 32 + row;
    float ss = 0.f;
#pragma unroll
    for (int q = 0; q < 8; ++q) { const float v = outf[row][part * 8 + q]; ss += v * v; }
    ss += __shfl_xor(ss, 1); ss += __shfl_xor(ss, 2); ss += __shfl_xor(ss, 4);
    const float rr = rsqrtf(ss * (1.f / 64.f) + 1e-6f);
    const int j0 = (part & 3) * 8, hi = part >> 2;
    const float* gain = p.in[9] + l * 64;
    const int nc = nn > 510 ? 510 : nn;
    const size_t prow = (size_t)b * S + 16 * nc + 31;
    const float* COS = (const float*)(ws + O_COS) + prow * 32;
    const float* SIN = (const float*)(ws + O_SIN) + prow * 32;
    float o[8];
#pragma unroll
    for (int q = 0; q < 8; ++q) {
      const float x1 = outf[row][j0 + q] * rr * gain[j0 + q], x2 = outf[row][j0 + q + 32] * rr * gain[j0 + q + 32];
      const float cs = COS[j0 + q], sn = SIN[j0 + q];
      const float v = hi ? (x2 * cs + x1 * sn) : (x1 * cs - x2 * sn);
      o[q] = nn > 510 ? 0.f : v;
    }
    *(uint4*)((bf16_t*)(ws + O_KCMP) + ((size_t)(b * 2 + g) * 512 + nn) * 64 + hi * 32 + j0) = pack8(o);
  } else {
    const int d = tid & 63, ng = tid >> 6;
    float o[8];
#pragma unroll
    for (int q = 0; q < 8; ++q) { const int nn = nb * 32 + ng * 8 + q; o[q] = nn > 510 ? 0.f : outf[ng * 8 + q][d]; }
    *(uint4*)((bf16_t*)(ws + O_VCMPT) + ((size_t)(b * 2 + g) * 64 + d) * 512 + nb * 32 + ng * 8) = pack8(o);
  }
  __syncthreads();
}

DI void kmean_task(const Params& p, int task, char* smem) {
  char* ws = p.ws;
  float* red = (float*)smem;
  const int tid = otid(), cq = task & 3, blk = (task >> 2) & 31, b = task >> 7;
  const int cp = tid & 63, tq = tid >> 6;
  const bf16_t* kp = (const bf16_t*)(ws + O_KB) + ((size_t)b * S + blk * 256 + tq * 64) * 512 + cq * 128 + cp * 2;
  float a0 = 0.f, a1 = 0.f;
#pragma unroll 8
  for (int k = 0; k < 64; ++k) { const unsigned u = *(const unsigned*)(kp + (size_t)k * 512); a0 += bf_lo(u); a1 += bf_hi(u); }
  red[tq * 128 + cp * 2] = a0; red[tq * 128 + cp * 2 + 1] = a1;
  __syncthreads();
  if (tid < 128) {
    const float s = (red[tid] + red[128 + tid] + red[256 + tid] + red[384 + tid]) * (1.f / 256.f);
    const int col = cq * 128 + tid, h = col >> 6, d = col & 63;
    ((bf16_t*)(ws + O_KMEAN))[((size_t)(b * 8 + h) * 32 + blk) * 64 + d] = (bf16_t)(pk2(s, 0.f) & 0xffff);
  }
  __syncthreads();
}

struct AttnSmem {
  bf16_t k[2][64][72];
  bf16_t vt[2][64][72];
  float imp[32][136];
  unsigned selmask[32][4];
};
static_assert(sizeof(AttnSmem) <= SMEM_BYTES, "smem");

DI void ld_tile(int tid, const bf16_t* __restrict__ kp, int kstride, const bf16_t* __restrict__ vp, int vstride, u32x4 (&r)[4]) {
#pragma unroll
  for (int i = 0; i < 2; ++i) {
    const int id = tid + 256 * i, row = id >> 3, c = id & 7;
    r[i] = *(const u32x4*)(kp + (size_t)row * kstride + c * 8);
    r[2 + i] = *(const u32x4*)(vp + (size_t)row * vstride + c * 8);
  }
}
DI void st_tile(int tid, AttnSmem& sm, int buf, const u32x4 (&r)[4]) {
#pragma unroll
  for (int i = 0; i < 2; ++i) {
    const int id = tid + 256 * i, row = id >> 3, c = id & 7;
    *(u32x4*)&sm.k[buf][row][c * 8] = r[i];
    *(u32x4*)&sm.vt[buf][row][c * 8] = r[2 + i];
  }
}

template <class Body>
DI void kv_loop(int tid, AttnSmem& sm, const bf16_t* kp, int kstride, const bf16_t* vp, int vstride, int tlo, int thi, Body body) {
  const int n = thi - tlo;
  if (n <= 0) return;
  u32x4 r0[4], r1[4];
  ld_tile(tid, kp + (size_t)tlo * 64 * kstride, kstride, vp + (size_t)tlo * 64, vstride, r0);
  if (n > 1) ld_tile(tid, kp + (size_t)(tlo + 1) * 64 * kstride, kstride, vp + (size_t)(tlo + 1) * 64, vstride, r1);
  __syncthreads();
  st_tile(tid, sm, 0, r0);
  __syncthreads();
  for (int i = 0; i < n; i += 2) {
    if (i + 2 < n) ld_tile(tid, kp + (size_t)(tlo + i + 2) * 64 * kstride, kstride, vp + (size_t)(tlo + i + 2) * 64, vstride, r0);
    body(tlo + i, 0);
    if (i + 1 < n) st_tile(tid, sm, 1, r1);
    __syncthreads();
    if (i + 1 >= n) break;
    if (i + 3 < n) ld_tile(tid, kp + (size_t)(tlo + i + 3) * 64 * kstride, kstride, vp + (size_t)(tlo + i + 3) * 64, vstride, r1);
    body(tlo + i + 1, 1);
    if (i + 2 < n) st_tile(tid, sm, 0, r0);
    __syncthreads();
  }
}

DI void qk_scores(int lane, const bf16_t (*sk)[72], int kk, const bf16x8 (&q)[4], f32x16& s) {
  const int r = lane & 31, half = lane >> 5;
  const int pr = (r & 0x13) | ((r & 4) << 1) | ((r & 8) >> 1);
#pragma unroll
  for (int i = 0; i < 16; ++i) s[i] = 0.f;
#pragma unroll
  for (int ks = 0; ks < 4; ++ks) {
    const bf16x8 a = *(const bf16x8*)&sk[kk * 32 + pr][ks * 16 + half * 8];
    s = MFMA32(a, q[ks], s);
  }
}

DI float max16(const f32x16& s) {
  float m = s[0];
#pragma unroll
  for (int j = 1; j < 16; ++j) m = fmaxf(m, s[j]);
  return m;
}
DI f32x2 mk2(float a, float b) { f32x2 r = {a, b}; return r; }
template <bool ELEM>
DI void attn_step64(int lane, const bf16_t (*sk)[72], const bf16_t (*svt)[72], const bf16x8 (&q)[4], f32x16 (&o)[2], float& m, float& l,
                    bool lane_on, int key0, int lo, int hi) {
  const int r = lane & 31, half = lane >> 5;
  const int pr = (r & 0x13) | ((r & 4) << 1) | ((r & 8) >> 1);
  f32x16 s0, s1;
#pragma unroll
  for (int i = 0; i < 16; ++i) { s0[i] = 0.f; s1[i] = 0.f; }
#pragma unroll
  for (int ks = 0; ks < 4; ++ks) {
    const bf16x8 a0 = *(const bf16x8*)&sk[pr][ks * 16 + half * 8];
    const bf16x8 a1 = *(const bf16x8*)&sk[32 + pr][ks * 16 + half * 8];
    s0 = MFMA32(a0, q[ks], s0);
    s1 = MFMA32(a1, q[ks], s1);
  }
  if (ELEM) {
#pragma unroll
    for (int i = 0; i < 16; ++i) {
      const int key = key0 + (i & 7) + 8 * half + 16 * (i >> 3);
      const bool ok0 = lane_on && key >= lo && key <= hi;
      const bool ok1 = lane_on && (key + 32) >= lo && (key + 32) <= hi;
      s0[i] = ok0 ? s0[i] : NEGF;
      s1[i] = ok1 ? s1[i] : NEGF;
    }
  }
  float mx = fmaxf(max16(s0), max16(s1));
  if (!ELEM && !lane_on) mx = NEGF;
  mx = xhalf_max(mx);
  const bool upd = (mx - m) * L2E > 8.f;
  if (__any(upd)) {
    const float mnew = upd ? mx : m;
    const float alpha = __builtin_amdgcn_exp2f((m - mnew) * L2E);
    l *= alpha;
    m = mnew;
    const f32x2 al2 = mk2(alpha, alpha);
#pragma unroll
    for (int mt = 0; mt < 2; ++mt)
#pragma unroll
      for (int i = 0; i < 16; i += 2) { f32x2 v = mk2(o[mt][i], o[mt][i + 1]); v = v * al2; o[mt][i] = v.x; o[mt][i + 1] = v.y; }
  }
  float mb = (m < -1e29f) ? 0.f : m * L2E;
  if (!ELEM && !lane_on) mb = __builtin_inff();
  const f32x2 l2e2 = mk2(L2E, L2E), nmb2 = mk2(-mb, -mb);
  f32x2 sum0 = mk2(0.f, 0.f), sum1 = mk2(0.f, 0.f);
#pragma unroll
  for (int i = 0; i < 16; i += 2) {
    f32x2 v0 = __builtin_elementwise_fma(mk2(s0[i], s0[i + 1]), l2e2, nmb2);
    f32x2 v1 = __builtin_elementwise_fma(mk2(s1[i], s1[i + 1]), l2e2, nmb2);
    v0.x = __builtin_amdgcn_exp2f(v0.x); v0.y = __builtin_amdgcn_exp2f(v0.y);
    v1.x = __builtin_amdgcn_exp2f(v1.x); v1.y = __builtin_amdgcn_exp2f(v1.y);
    sum0 += v0; sum1 += v1;
    s0[i] = v0.x; s0[i + 1] = v0.y; s1[i] = v1.x; s1[i + 1] = v1.y;
  }
  sum0 += sum1;
  l += sum0.x + sum0.y;
#pragma unroll
  for (int j = 0; j < 4; ++j) {
    uint4 pu;
    if (j < 2) { pu.x = pk2(s0[8 * j], s0[8 * j + 1]); pu.y = pk2(s0[8 * j + 2], s0[8 * j + 3]); pu.z = pk2(s0[8 * j + 4], s0[8 * j + 5]); pu.w = pk2(s0[8 * j + 6], s0[8 * j + 7]); }
    else { const int jj = j - 2; pu.x = pk2(s1[8 * jj], s1[8 * jj + 1]); pu.y = pk2(s1[8 * jj + 2], s1[8 * jj + 3]); pu.z = pk2(s1[8 * jj + 4], s1[8 * jj + 5]); pu.w = pk2(s1[8 * jj + 6], s1[8 * jj + 7]); }
    const bf16x8 pb = __builtin_bit_cast(bf16x8, pu);
#pragma unroll
    for (int mt = 0; mt < 2; ++mt) {
      const bf16x8 a = *(const bf16x8*)&svt[mt * 32 + r][j * 16 + half * 8];
      o[mt] = MFMA32(a, pb, o[mt]);
    }
  }
}

DI void zero_o(f32x16 (&o)[2]) {
#pragma unroll
  for (int a = 0; a < 2; ++a)
#pragma unroll
    for (int i = 0; i < 16; ++i) o[a][i] = 0.f;
}

DI void nsa_tile(const Params& p, int rank, char* smem) {
  char* ws = p.ws;
  AttnSmem& sm = *(AttnSmem*)smem;
  const int bg = rank & 3, b = bg >> 1, g = bg & 1, t0 = (255 - (rank >> 2)) * 32;
  const int tid = otid(), lane = tid & 63, w = tid >> 6, c = lane & 31, half = lane >> 5;
  const int tokl = w * 8 + (c >> 2), hh = c & 3, t = t0 + tokl, head = g * 4 + hh;
  __syncthreads();
  for (int i = tid; i < 32 * 136; i += 256) (&sm.imp[0][0])[i] = 0.f;
  bf16x8 q[4];
  {
    const bf16_t* qp = (const bf16_t*)(ws + O_QA) + ((size_t)b * S + t) * 512 + head * 64 + half * 8;
#pragma unroll
    for (int ks = 0; ks < 4; ++ks) q[ks] = *(const bf16x8*)(qp + ks * 16);
  }
  const float* gap = (const float*)(ws + O_GA) + ((size_t)b * S + t) * 24 + head * 3;
  const float g0 = gap[0], g1 = gap[1], g2 = gap[2];
  f32x16 y[2];
  zero_o(y);

  {
    const int nlim = (t - 31) >> 4;
    const int ntile = ((t0 >> 4) >> 6) + 1;
    const bf16_t* kp = (const bf16_t*)(ws + O_KCMP) + (size_t)(b * 2 + g) * 512 * 64;
    const bf16_t* vp = (const bf16_t*)(ws + O_VCMPT) + (size_t)(b * 2 + g) * 64 * 512;
    f32x16 o[2];
    zero_o(o);
    float m = NEGF, l = 0.f;
    kv_loop(tid, sm, kp, 64, vp, 512, 0, ntile, [&](int it, int buf) {
      attn_step64<true>(lane, sm.k[buf], sm.vt[buf], q, o, m, l, true, it * 64, 0, nlim);
    });
    const float lt = xhalf_sum(l);
    const float inv = lt > 0.f ? 1.f / lt : 0.f;
    const float sc = g0 * inv;
#pragma unroll
    for (int mt = 0; mt < 2; ++mt)
#pragma unroll
      for (int i = 0; i < 16; ++i) y[mt][i] += sc * o[mt][i];
    const float mbl = (m < -1e29f) ? 0.f : m * L2E;
    kv_loop(tid, sm, kp, 64, vp, 512, 0, ntile, [&](int it, int buf) {
#pragma unroll
      for (int kk = 0; kk < 2; ++kk) {
        f32x16 s;
        qk_scores(lane, sm.k[buf], kk, q, s);
        float pn[16];
#pragma unroll
        for (int i = 0; i < 16; ++i) {
          const int n = it * 64 + kk * 32 + (i & 7) + 8 * half + 16 * (i >> 3);
          const float e = __builtin_amdgcn_exp2f(fmaf(s[i], L2E, -mbl)) * inv;
          pn[i] = (n <= nlim) ? e : 0.f;
        }
#pragma unroll
        for (int j = 0; j < 2; ++j) {
          float v0 = (pn[8 * j] + pn[8 * j + 1]) + (pn[8 * j + 2] + pn[8 * j + 3]);
          float v1 = (pn[8 * j + 4] + pn[8 * j + 5]) + (pn[8 * j + 6] + pn[8 * j + 7]) + pn[8 * j + 3];
          float v2 = pn[8 * j + 7];
          v0 = quad_sum(v0); v1 = quad_sum(v1); v2 = quad_sum(v2);
          if (hh == 0) {
            const int Ja = (it * 64 + kk * 32 + 16 * j + 8 * half) >> 2;
            if (Ja < 128) atomicAdd(&sm.imp[tokl][Ja], v0);
            if (Ja + 1 < 128) atomicAdd(&sm.imp[tokl][Ja + 1], v1);
            if (Ja + 2 < 128) atomicAdd(&sm.imp[tokl][Ja + 2], v2);
          }
        }
      }
    });
  }
  __syncthreads();
  {
    const int tk = w * 8 + (lane >> 3), sub = lane & 7, tt = t0 + tk, jown = tt >> 6;
    unsigned key[16];
#pragma unroll
    for (int i = 0; i < 16; ++i) {
      const int J = i * 8 + sub;
      float v = sm.imp[tk][J];
      if (J == 0 || J == jown) v = 1e4f;
      if (J * 64 > tt) v = NEGF;
      const unsigned u = __float_as_uint(v);
      const unsigned ok = (u & 0x80000000u) ? ~u : (u | 0x80000000u);
      key[i] = (ok & ~127u) | (unsigned)(127 - J);
    }
    unsigned Tk = 0;
    for (int bit = 31; bit >= 0; --bit) {
      const unsigned cand = Tk | (1u << bit);
      int cnt = 0;
#pragma unroll
      for (int i = 0; i < 16; ++i) cnt += (key[i] >= cand) ? 1 : 0;
      cnt = oct_sum(cnt);
      if (cnt >= 16) Tk = cand;
    }
    unsigned wb[4] = {0u, 0u, 0u, 0u};
#pragma unroll
    for (int i = 0; i < 16; ++i) if (key[i] >= Tk) wb[i >> 2] |= 1u << (8 * (i & 3) + sub);
#pragma unroll
    for (int k = 0; k < 4; ++k) wb[k] = oct_or(wb[k]);
    if (sub == 0) { sm.selmask[tk][0] = wb[0]; sm.selmask[tk][1] = wb[1]; sm.selmask[tk][2] = wb[2]; sm.selmask[tk][3] = wb[3]; }
  }
  __syncthreads();
  {
    const int jown = t0 >> 6;
    const bf16_t* kp = (const bf16_t*)(ws + O_KS) + (size_t)b * S * 128 + g * 64;
    const bf16_t* vp = (const bf16_t*)(ws + O_VST) + (size_t)(b * 2 + g) * 64 * S;
    f32x16 o[2];
    zero_o(o);
    float m = NEGF, l = 0.f;
    kv_loop(tid, sm, kp, 128, vp, S, 0, jown, [&](int it, int buf) {
      const bool on = (sm.selmask[tokl][it >> 5] >> (it & 31)) & 1u;
      if (__any(on)) attn_step64<false>(lane, sm.k[buf], sm.vt[buf], q, o, m, l, on, it * 64, 0, t);
    });
    kv_loop(tid, sm, kp, 128, vp, S, jown, jown + 1, [&](int it, int buf) {
      const bool on = (sm.selmask[tokl][it >> 5] >> (it & 31)) & 1u;
      attn_step64<true>(lane, sm.k[buf], sm.vt[buf], q, o, m, l, on, it * 64, 0, t);
    });
    const float lt = xhalf_sum(l);
    const float sc = g1 * (lt > 0.f ? 1.f / lt : 0.f);
#pragma unroll
    for (int mt = 0; mt < 2; ++mt)
#pragma unroll
      for (int i = 0; i < 16; ++i) y[mt][i] += sc * o[mt][i];
  }
  {
    const int tl0 = (t0 - 511) < 0 ? 0 : ((t0 - 511) >> 6);
    const bf16_t* kp = (const bf16_t*)(ws + O_KW) + (size_t)b * S * 128 + g * 64;
    const bf16_t* vp = (const bf16_t*)(ws + O_VWT) + (size_t)(b * 2 + g) * 64 * S;
    f32x16 o[2];
    zero_o(o);
    float m = NEGF, l = 0.f;
    kv_loop(tid, sm, kp, 128, vp, S, tl0, (t0 >> 6) + 1, [&](int it, int buf) {
      attn_step64<true>(lane, sm.k[buf], sm.vt[buf], q, o, m, l, true, it * 64, t - 511, t);
    });
    const float lt = xhalf_sum(l);
    const float sc = g2 * (lt > 0.f ? 1.f / lt : 0.f);
#pragma unroll
    for (int mt = 0; mt < 2; ++mt)
#pragma unroll
      for (int i = 0; i < 16; ++i) y[mt][i] += sc * o[mt][i];
  }
  {
    bf16_t* yp = (bf16_t*)(ws + O_YA) + ((size_t)b * S + t) * 512 + head * 64;
#pragma unroll
    for (int mt = 0; mt < 2; ++mt)
#pragma unroll
      for (int g4 = 0; g4 < 4; ++g4) {
        uint2 u; u.x = pk2(y[mt][4 * g4], y[mt][4 * g4 + 1]); u.y = pk2(y[mt][4 * g4 + 2], y[mt][4 * g4 + 3]);
        *(uint2*)(yp + 32 * mt + 8 * g4 + 4 * half) = u;
      }
  }
}

DI void moba_tile(const Params& p, int rank, char* smem) {
  char* ws = p.ws;
  AttnSmem& sm = *(AttnSmem*)smem;
  const int bh = rank & 15, b = bh >> 3, h = bh & 7, s0 = (63 - (rank >> 4)) * 128, own = s0 >> 8;
  const int tid = otid(), lane = tid & 63, w = tid >> 6, c = lane & 31, half = lane >> 5;
  const int t = s0 + w * 32 + c;
  bf16x8 q[4];
  {
    const bf16_t* qp = (const bf16_t*)(ws + O_QB) + ((size_t)b * S + t) * 512 + h * 64 + half * 8;
#pragma unroll
    for (int ks = 0; ks < 4; ++ks) q[ks] = *(const bf16x8*)(qp + ks * 16);
  }
  unsigned selbits = 0;
  if (own > 0) {
    f32x16 s;
#pragma unroll
    for (int i = 0; i < 16; ++i) s[i] = 0.f;
    const bf16_t* km = (const bf16_t*)(ws + O_KMEAN) + ((size_t)(b * 8 + h) * 32 + c) * 64 + half * 8;
#pragma unroll
    for (int ks = 0; ks < 4; ++ks) { const bf16x8 a = *(const bf16x8*)(km + ks * 16); s = MFMA32(a, q[ks], s); }
    unsigned key[16];
#pragma unroll
    for (int i = 0; i < 16; ++i) {
      const int blk = crow(i, half);
      const unsigned u = __float_as_uint(s[i]);
      const unsigned ok = (u & 0x80000000u) ? ~u : (u | 0x80000000u);
      key[i] = blk < own ? ((ok & ~31u) | (unsigned)(31 - blk)) : 0u;
    }
#pragma unroll
    for (int rnd = 0; rnd < 3; ++rnd) {
      unsigned mx = 0;
#pragma unroll
      for (int i = 0; i < 16; ++i) mx = key[i] > mx ? key[i] : mx;
      const unsigned ox = (unsigned)__shfl_xor((int)mx, 32);
      const unsigned win = mx > ox ? mx : ox;
      if (win != 0u) selbits |= 1u << (31 - (win & 31u));
#pragma unroll
      for (int i = 0; i < 16; ++i) key[i] = (key[i] == win) ? 0u : key[i];
    }
  }
  const bf16_t* kp = (const bf16_t*)(ws + O_KB) + (size_t)b * S * 512 + h * 64;
  const bf16_t* vp = (const bf16_t*)(ws + O_VBT) + (size_t)(b * 8 + h) * 64 * S;
  f32x16 o[2];
  zero_o(o);
  float m = NEGF, l = 0.f;
  const int tq_hi = s0 + w * 32 + 31;
  kv_loop(tid, sm, kp, 512, vp, S, 0, own * 4, [&](int it, int buf) {
    const bool on = (selbits >> (it >> 2)) & 1u;
    if (__any(on)) attn_step64<false>(lane, sm.k[buf], sm.vt[buf], q, o, m, l, on, it * 64, 0, t);
  });
  kv_loop(tid, sm, kp, 512, vp, S, own * 4, ((s0 + 127) >> 6) + 1, [&](int it, int buf) {
    if (it * 64 <= tq_hi) attn_step64<true>(lane, sm.k[buf], sm.vt[buf], q, o, m, l, true, it * 64, 0, t);
  });
  const float lt = xhalf_sum(l);
  const float inv = lt > 0.f ? 1.f / lt : 0.f;
  bf16_t* yp = (bf16_t*)(ws + O_YB) + ((size_t)b * S + t) * 512 + h * 64;
#pragma unroll
  for (int mt = 0; mt < 2; ++mt)
#pragma unroll
    for (int g4 = 0; g4 < 4; ++g4) {
      uint2 u; u.x = pk2(o[mt][4 * g4] * inv, o[mt][4 * g4 + 1] * inv); u.y = pk2(o[mt][4 * g4 + 2] * inv, o[mt][4 * g4 + 3] * inv);
      *(uint2*)(yp + 32 * mt + 8 * g4 + 4 * half) = u;
    }
}


#define XB_TMO      128
#define XB_XCNT(j)  (256  + 64 * (j))
#define XB_XSUB(j)  (1280 + 64 * (j))
#define XB_XGEN(j)  (2304 + 64 * (j))
#define XB_TOP      3328
#define XB_TOPGEN   3392
#define XCD_BAR_WORDS 3456
#define XB_SPIN_CAP (1u << 20)
#define LAS __attribute__((address_space(3)))
DI unsigned xb_ld(unsigned* p)              { return __hip_atomic_load(p, __ATOMIC_RELAXED, __HIP_MEMORY_SCOPE_AGENT); }
DI unsigned xb_add(unsigned* p, unsigned v) { return __hip_atomic_fetch_add(p, v, __ATOMIC_RELAXED, __HIP_MEMORY_SCOPE_AGENT); }
DI unsigned xb_xcc_id() { return (unsigned)__builtin_amdgcn_s_getreg((3 << 11) | 20) & 0xFu; }
#define XB_SPIN(cond, bar) do { unsigned _sp = 0; while (cond) { __builtin_amdgcn_s_sleep(1); \
    if ((++_sp & 255u) == 0u) { if (xb_ld(&(bar)[XB_TMO])) break; if (_sp > XB_SPIN_CAP) { atomicAdd(&(bar)[XB_TMO], 1u); break; } } } } while (0)
struct XcdBarrier { unsigned* bar; unsigned x; volatile LAS unsigned* st; };
DI XcdBarrier xcd_barrier_post(unsigned* bar, volatile LAS unsigned* st) {
  XcdBarrier b; b.bar = bar; b.x = xb_xcc_id(); b.st = st;
  if (threadIdx.x == 0) (void)xb_add(&bar[XB_XCNT(b.x)], 1u);
  return b;
}
DI void xcd_barrier_complete(unsigned* bar, unsigned x, unsigned& nloc, unsigned& nx) {
  const unsigned G = gridDim.x * gridDim.y * gridDim.z;
  unsigned sum, cnt, mine, sp = 0u;
  for (;;) {
    sum = 0u; cnt = 0u; mine = 0u;
#pragma unroll
    for (unsigned j = 0; j < 16; ++j) { const unsigned c = xb_ld(&bar[XB_XCNT(j)]); sum += c; cnt += (c > 0u) ? 1u : 0u; mine = (j == x) ? c : mine; }
    if (sum == G) break;
    __builtin_amdgcn_s_sleep(1);
    if ((++sp & 255u) == 0u) { if (xb_ld(&bar[XB_TMO])) break; if (sp > XB_SPIN_CAP) { atomicAdd(&bar[XB_TMO], 1u); break; } }
  }
  nloc = mine > 0u ? mine : 1u; nx = cnt > 0u ? cnt : 1u;
}
DI void xcd_barrier(const XcdBarrier& b) {
  asm volatile("s_waitcnt vmcnt(0)" ::: "memory");
  __syncthreads();
  if (threadIdx.x == 0) {
    unsigned* bar = b.bar;
    __builtin_amdgcn_s_waitcnt(0);
    unsigned nloc = b.st[0], nx = b.st[1];
    if (nloc == 0u) { xcd_barrier_complete(bar, b.x, nloc, nx); b.st[0] = nloc; b.st[1] = nx; }
    const unsigned old = xb_add(&bar[XB_XSUB(b.x)], 1u);
    const unsigned gen = old / nloc;
    if (old + 1u == (gen + 1u) * nloc) {
      __builtin_amdgcn_fence(__ATOMIC_RELEASE, "agent");
      asm volatile("s_waitcnt vmcnt(0)" ::: "memory");
      const unsigned og = xb_add(&bar[XB_TOP], 1u);
      const unsigned tg = og / nx;
      if (og + 1u == (tg + 1u) * nx) xb_add(&bar[XB_TOPGEN], 1u);
      else XB_SPIN(xb_ld(&bar[XB_TOPGEN]) == tg, bar);
      __builtin_amdgcn_fence(__ATOMIC_ACQUIRE, "agent");
      xb_add(&bar[XB_XGEN(b.x)], 1u);
      asm volatile("s_waitcnt vmcnt(0)" ::: "memory");
    } else {
      XB_SPIN(xb_ld(&bar[XB_XGEN(b.x)]) == gen, bar);
      __builtin_amdgcn_fence(__ATOMIC_ACQUIRE, "agent");
      asm volatile("s_waitcnt vmcnt(0)" ::: "memory");
    }
  }
  __syncthreads();
}

__global__ void __launch_bounds__(256, 2) fwd_megakernel(Params p) {
  __shared__ __attribute__((aligned(16))) char smem[SMEM_BYTES];
  __shared__ uint4 xb_words;
  __shared__ int s_tile;
  char* ws = p.ws;
  if (ws == nullptr) { cg::grid_group grid = cg::this_grid(); grid.sync(); }
  if (threadIdx.x == 0) xb_words = make_uint4(0u, 0u, 0u, 0u);
  __syncthreads();
  const XcdBarrier xb = xcd_barrier_post((unsigned*)(ws + O_BAR), (volatile LAS unsigned*)&xb_words);
  const int G = gridDim.x, bid = blockIdx.x;
  const float* ADA = (const float*)(ws + O_ADA);
  float* X = (float*)(ws + O_X);

  for (int l = 0; l < NL; ++l) {
    if (l == 0) {
      for (int task = bid; task < CONV_TASKS + 384 + 2048; task += G) {
        if (task < CONV_TASKS) conv_task(p, 0, task, smem);
        else if (task < CONV_TASKS + 384) ada_task(p, task - CONV_TASKS, smem);
        else rope_task(p, task - CONV_TASKS - 384);
      }
      xcd_barrier(xb);
    }
    const float* ada_l = ADA + (size_t)l * 2 * 6144;
    const float* xin = (l == 0) ? p.in[0] : X;
    norm_rows(xin, p.in[5] + l * 1024, ada_l + 0, ada_l + 1024, (bf16_t*)(ws + O_H));
    xcd_barrier(xb);
    for (int idx = bid; idx < gemm_slots_big(39); idx += G) { int mt, nt; if (gemm_coords_big(idx, 39, mt, nt)) gemm_in_tile_big(p, l, mt, nt, smem); }
    xcd_barrier(xb);
    for (int task = bid; task < 128 + 256; task += G) {
      if (task < 128) cmp_tile(p, l, task, smem); else kmean_task(p, task - 128, smem);
    }
    xcd_barrier(xb);
    {
      unsigned* qctr = (unsigned*)(ws + O_BAR + 14336) + l * 16;
      for (;;) {
        __syncthreads();
        if (threadIdx.x == 0) s_tile = (int)atomicAdd(qctr, 1u);
        __syncthreads();
        const int rk = s_tile;
        const int nconv = (l + 1 < NL) ? CONV_TASKS : 0;
        if (rk >= 2048 + nconv) break;
        if (rk < 1024) nsa_tile(p, rk, smem);
        else if (rk < 1024 + nconv) conv_task(p, l + 1, rk - 1024, smem);
        else moba_tile(p, rk - 1024 - nconv, smem);
      }
      xcd_barrier(xb);
    }
    for (int idx = bid; idx < gemm_slots_big(8); idx += G) {
      int mt, nt;
      if (gemm_coords_big(idx, 8, mt, nt)) {
        gemm_up_pass_big((const bf16_t*)(ws + O_YA), (const bf16_t*)(ws + wdl(l) + O_WUPA), (const bf16_t*)(ws + O_GBR), 0, (bf16_t*)(ws + O_H), true, mt, nt, smem);
        gemm_up_pass_big((const bf16_t*)(ws + O_YB), (const bf16_t*)(ws + wdl(l) + O_WUPB), (const bf16_t*)(ws + O_GBR), 1024, (bf16_t*)(ws + O_H), false, mt, nt, smem);
      }
    }
    xcd_barrier(xb);
    for (int idx = bid; idx < gemm_slots_big(8); idx += G) {
      int mt, nt;
      if (gemm_coords_big(idx, 8, mt, nt)) gemm_res_tile_big((const bf16_t*)(ws + O_H), 1024, (const bf16_t*)(ws + wdl(l) + O_WOUT), 1024, xin, X, ada_l + 2048, mt, nt, smem);
    }
    xcd_barrier(xb);
    norm_rows(X, p.in[6] + l * 1024, ada_l + 3072, ada_l + 4096, (bf16_t*)(ws + O_H));
    xcd_barrier(xb);
    for (int idx = bid; idx < gemm_slots_big(44); idx += G) { int mt, nt; if (gemm_coords_big(idx, 44, mt, nt)) gemm_ffi_tile_big(p, l, mt, nt, smem); }
    xcd_barrier(xb);
    {
      float* xo = (l == NL - 1) ? p.out : X;
      for (int idx = bid; idx < gemm_slots_big(8); idx += G) {
        int mt, nt;
        if (gemm_coords_big(idx, 8, mt, nt)) gemm_res_tile_big((const bf16_t*)(ws + O_ACT), DFF, (const bf16_t*)(ws + wdl(l) + O_WFFO), DFF, X, xo, ada_l + 5120, mt, nt, smem);
      }
      if (l + 1 < NL) xcd_barrier(xb);
    }
  }
}

extern "C" void kernel_launch(void* const* d_in, const int* in_sizes, int n_in, void* d_out, int out_size,
                              void* d_ws, size_t ws_size, hipStream_t stream) {
  static int grid_blocks = 0;
  if (!grid_blocks) {
    int dev = 0, cus = 0, per_cu = 0;
    (void)hipGetDevice(&dev);
    (void)hipDeviceGetAttribute(&cus, hipDeviceAttributeMultiprocessorCount, dev);
    (void)hipOccupancyMaxActiveBlocksPerMultiprocessor(&per_cu, fwd_megakernel, 256, 0);
    if (per_cu > 2) per_cu = 2;
    if (per_cu < 1) per_cu = 1;
    grid_blocks = cus * per_cu;
    if (ws_size < WS_TOTAL) fprintf(stderr, "kernel_launch: workspace too small: %zu < %zu\n", ws_size, (size_t)WS_TOTAL);
  }
  Params p{};
  for (int i = 0; i < 22; ++i) p.in[i] = (const float*)d_in[i];
  p.out = (float*)d_out;
  p.ws = (char*)d_ws;
  (void)hipMemsetAsync((char*)d_ws + O_BAR, 0, 16384, stream);
  void* args[] = {&p};
  hipError_t e = hipLaunchCooperativeKernel((void*)fwd_megakernel, dim3(grid_blocks), dim3(256), args, 0, stream);
  if (e != hipSuccess) fprintf(stderr, "cooperative launch failed: %s (grid %d)\n", hipGetErrorString(e), grid_blocks);
}
```

```cpp
#include <hip/hip_runtime.h>
#include <hip/hip_cooperative_groups.h>
#include <cstdio>
#include <cstdint>
namespace cg = cooperative_groups;

typedef unsigned short bf16_t;
typedef short bf16x8 __attribute__((ext_vector_type(8)));
typedef float f32x16 __attribute__((ext_vector_type(16)));
typedef float f32x2 __attribute__((ext_vector_type(2)));
typedef __bf16 bf2_t __attribute__((ext_vector_type(2)));
typedef unsigned u32x4 __attribute__((ext_vector_type(4)));
#define DI __device__ __forceinline__
#define MFMA32(a, b, c) __builtin_amdgcn_mfma_f32_32x32x16_bf16((a), (b), (c), 0, 0, 0)

constexpr int NB = 2, S = 8192, D = 1024, NL = 4, T = NB * S;
constexpr int NIN = 4888, NPIN = 4992, DFF = 2816, NFFI = 5632;
constexpr float L2E = 1.4426950408889634f;
constexpr float NEGF = -1e30f;

constexpr size_t O_WIN = 0;
constexpr size_t O_WUPA = O_WIN + (size_t)NPIN * 1024 * 2;
constexpr size_t O_WUPB = O_WUPA + (size_t)1024 * 512 * 2;
constexpr size_t O_WOUT = O_WUPB + (size_t)1024 * 512 * 2;
constexpr size_t O_WFFI = O_WOUT + (size_t)1024 * 1024 * 2;
constexpr size_t O_WFFO = O_WFFI + (size_t)NFFI * 1024 * 2;
constexpr size_t O_CKW1 = O_WFFO + (size_t)1024 * DFF * 2;
constexpr size_t O_CVW1 = O_CKW1 + (size_t)128 * 2048 * 2;
constexpr size_t O_CKW2 = O_CVW1 + (size_t)128 * 2048 * 2;
constexpr size_t O_CVW2 = O_CKW2 + (size_t)64 * 128 * 2;
constexpr size_t O_ADA = O_CVW2 + (size_t)64 * 128 * 2;
constexpr size_t O_COS = O_ADA + (size_t)NL * NB * 6144 * 4;
constexpr size_t O_SIN = O_COS + (size_t)T * 32 * 4;
constexpr size_t O_X = O_SIN + (size_t)T * 32 * 4;
constexpr size_t O_H = O_X + (size_t)T * 1024 * 4;
constexpr size_t O_QA = O_H + (size_t)T * 1024 * 2;
constexpr size_t O_KC = O_QA + (size_t)T * 512 * 2;
constexpr size_t O_VC = O_KC + (size_t)T * 128 * 2;
constexpr size_t O_KS = O_VC + (size_t)T * 128 * 2;
constexpr size_t O_KW = O_KS + (size_t)T * 128 * 2;
constexpr size_t O_VST = O_KW + (size_t)T * 128 * 2;
constexpr size_t O_VWT = O_VST + (size_t)T * 128 * 2;
constexpr size_t O_QB = O_VWT + (size_t)T * 128 * 2;
constexpr size_t O_KB = O_QB + (size_t)T * 512 * 2;
constexpr size_t O_VBT = O_KB + (size_t)T * 512 * 2;
constexpr size_t O_GBR = O_VBT + (size_t)T * 512 * 2;
constexpr size_t O_GA = O_GBR + (size_t)T * 2048 * 2;
constexpr size_t O_KCMP = O_GA + (size_t)T * 24 * 4;
constexpr size_t O_VCMPT = O_KCMP + (size_t)NB * 2 * 512 * 64 * 2;
constexpr size_t O_KMEAN = O_VCMPT + (size_t)NB * 2 * 512 * 64 * 2;
constexpr size_t O_YA = O_KMEAN + (size_t)NB * 8 * 32 * 64 * 2;
constexpr size_t O_YB = O_YA + (size_t)T * 512 * 2;
constexpr size_t WS_END = O_YB + (size_t)T * 512 * 2;
constexpr size_t O_BAR = WS_END;
constexpr size_t O_W2 = O_BAR + 16384;
constexpr size_t WSZ = O_ADA - O_WIN;
constexpr size_t WS_TOTAL = O_W2 + WSZ;
__host__ __device__ constexpr size_t wdl(int l) { return (l & 1) ? (O_W2 - O_WIN) : 0; }
constexpr size_t O_ACT = O_QA;
static_assert((size_t)T * DFF * 2 <= O_GA - O_QA, "ACT alias");

struct Params {
  const float* in[22];
  float* out;
  char* ws;
};

constexpr int SMEM_BYTES = 73728;

DI float xhalf_max(float v) { auto r = __builtin_amdgcn_permlane32_swap(__float_as_uint(v), __float_as_uint(v), false, false); return fmaxf(__uint_as_float(r[0]), __uint_as_float(r[1])); }
DI float xhalf_sum(float v) { auto r = __builtin_amdgcn_permlane32_swap(__float_as_uint(v), __float_as_uint(v), false, false); return __uint_as_float(r[0]) + __uint_as_float(r[1]); }
template <int CTRL> DI unsigned dpp_u(unsigned v) { return (unsigned)__builtin_amdgcn_update_dpp(0, (int)v, CTRL, 0xf, 0xf, true); }
DI float quad_sum(float v) { v += __uint_as_float(dpp_u<0xB1>(__float_as_uint(v))); v += __uint_as_float(dpp_u<0x4E>(__float_as_uint(v))); return v; }
DI int oct_sum(int v) { v += (int)dpp_u<0xB1>((unsigned)v); v += (int)dpp_u<0x4E>((unsigned)v); v += (int)dpp_u<0x141>((unsigned)v); return v; }
DI unsigned oct_or(unsigned v) { v |= dpp_u<0xB1>(v); v |= dpp_u<0x4E>(v); v |= dpp_u<0x141>(v); return v; }
DI int otid() { int t = threadIdx.x; asm volatile("" : "+v"(t)); return t; }
DI unsigned pk2(float a, float b) { f32x2 v = {a, b}; bf2_t r = __builtin_convertvector(v, bf2_t); return __builtin_bit_cast(unsigned, r); }
DI float bf_lo(unsigned u) { return __uint_as_float(u << 16); }
DI float bf_hi(unsigned u) { return __uint_as_float(u & 0xffff0000u); }
DI float bf2f(bf16_t h) { return __uint_as_float(((unsigned)h) << 16); }
DI int crow(int i, int h) { return (i & 3) + 8 * (i >> 2) + 4 * h; }
DI float sigmoidf_(float x) { return 1.f / (1.f + __expf(-x)); }
DI uint4 pack8(const float* v) { uint4 r; r.x = pk2(v[0], v[1]); r.y = pk2(v[2], v[3]); r.z = pk2(v[4], v[5]); r.w = pk2(v[6], v[7]); return r; }

DI int map_in(int n) {
  if (n < 1280) return n;
  if (n < 4864) return n + 24;
  if (n < 4888) return n - 4864 + 1280;
  return -1;
}
DI int map_ffi(int n) {
  const int tile = n >> 7, within = n & 127, wn = within >> 6, sub = within & 63, isup = sub >> 5, c = sub & 31;
  return (isup ? DFF : 0) + tile * 64 + wn * 32 + c;
}

template <int KT>
DI void conv_tile(const float* __restrict__ src, int srcN, int K, bf16_t* __restrict__ dst, int mode, int nt, int kg, char* smem) {
  float (*st)[65] = (float (*)[65])smem;
  const int tid = otid(), j = tid & 63, i0 = tid >> 6;
  const int n0 = nt * 64, k0 = kg * 64 * KT;
  int ns = n0 + j;
  if (mode == 1) ns = map_in(ns); else if (mode == 2) ns = map_ffi(ns);
  float v[KT * 16];
#pragma unroll
  for (int ii = 0; ii < KT * 16; ++ii) {
    const int k = i0 + 4 * ii;
    v[ii] = ns >= 0 ? src[(size_t)(k0 + k) * srcN + ns] : 0.f;
  }
#pragma unroll
  for (int ii = 0; ii < KT * 16; ++ii) st[i0 + 4 * ii][j] = v[ii];
  __syncthreads();
  const int nrow = tid >> 2, kc = (tid & 3) * 16;
#pragma unroll
  for (int sub = 0; sub < KT; ++sub) {
    float o[16];
#pragma unroll
    for (int q = 0; q < 16; ++q) o[q] = st[sub * 64 + kc + q][nrow];
    uint4* dp = (uint4*)(dst + (size_t)(n0 + nrow) * K + k0 + sub * 64 + kc);
    dp[0] = pack8(o);
    dp[1] = pack8(o + 8);
  }
  __syncthreads();
}

constexpr int CONV_TASKS = 78 * 4 + 32 + 32 + 64 + 88 * 4 + 16 * 11 + 16 + 16 + 1 + 1;

DI void conv_task(const Params& p, int l, int task, char* smem) {
  char* ws = p.ws + wdl(l);
  int t = task;
  if (t < 78 * 4) { conv_tile<4>(p.in[7] + (size_t)l * 1024 * NIN, NIN, 1024, (bf16_t*)(ws + O_WIN), 1, t % 78, t / 78, smem); return; }
  t -= 78 * 4;
  if (t < 32) { conv_tile<4>(p.in[17] + (size_t)l * 512 * 1024, 1024, 512, (bf16_t*)(ws + O_WUPA), 0, t % 16, t / 16, smem); return; }
  t -= 32;
  if (t < 32) { conv_tile<4>(p.in[18] + (size_t)l * 512 * 1024, 1024, 512, (bf16_t*)(ws + O_WUPB), 0, t % 16, t / 16, smem); return; }
  t -= 32;
  if (t < 64) { conv_tile<4>(p.in[19] + (size_t)l * 1024 * 1024, 1024, 1024, (bf16_t*)(ws + O_WOUT), 0, t % 16, t / 16, smem); return; }
  t -= 64;
  if (t < 88 * 4) { conv_tile<4>(p.in[20] + (size_t)l * 1024 * NFFI, NFFI, 1024, (bf16_t*)(ws + O_WFFI), 2, t % 88, t / 88, smem); return; }
  t -= 88 * 4;
  if (t < 16 * 11) { conv_tile<4>(p.in[21] + (size_t)l * DFF * 1024, 1024, DFF, (bf16_t*)(ws + O_WFFO), 0, t % 16, t / 16, smem); return; }
  t -= 16 * 11;
  if (t < 16) { conv_tile<4>(p.in[11] + (size_t)l * 2048 * 128, 128, 2048, (bf16_t*)(ws + O_CKW1), 0, t % 2, t / 2, smem); return; }
  t -= 16;
  if (t < 16) { conv_tile<4>(p.in[13] + (size_t)l * 2048 * 128, 128, 2048, (bf16_t*)(ws + O_CVW1), 0, t % 2, t / 2, smem); return; }
  t -= 16;
  if (t < 1) { conv_tile<2>(p.in[12] + (size_t)l * 128 * 64, 64, 128, (bf16_t*)(ws + O_CKW2), 0, 0, 0, smem); return; }
  conv_tile<2>(p.in[14] + (size_t)l * 128 * 64, 64, 128, (bf16_t*)(ws + O_CVW2), 0, 0, 0, smem);
}

DI void ada_task(const Params& p, int task, char* smem) {
  float* sc = (float*)smem;
  float* red = sc + 2048;
  const int tid = otid(), l = task / 96, n0 = (task % 96) * 64;
  for (int i = tid; i < 2048; i += 256) { const float c = p.in[1][i]; sc[i] = c / (1.f + __expf(-c)); }
  __syncthreads();
  const int j = tid & 63, kq = tid >> 6;
  const float* w = p.in[3] + ((size_t)l * 1024 + kq * 256) * 6144 + n0 + j;
  float a0 = 0.f, a1 = 0.f;
#pragma unroll 8
  for (int k = 0; k < 256; ++k) { const float wv = w[(size_t)k * 6144]; a0 += sc[kq * 256 + k] * wv; a1 += sc[1024 + kq * 256 + k] * wv; }
  red[(kq * 2 + 0) * 64 + j] = a0; red[(kq * 2 + 1) * 64 + j] = a1;
  __syncthreads();
  if (tid < 128) {
    const int b = tid >> 6;
    float s = red[(0 * 2 + b) * 64 + j] + red[(1 * 2 + b) * 64 + j] + red[(2 * 2 + b) * 64 + j] + red[(3 * 2 + b) * 64 + j];
    ((float*)(p.ws + O_ADA))[((size_t)l * 2 + b) * 6144 + n0 + j] = s + p.in[4][(size_t)l * 6144 + n0 + j];
  }
  __syncthreads();
}

DI void rope_task(const Params& p, int task) {
  const int tid = otid(), row = task * 8 + (tid >> 5), i = tid & 31;
  const int pos = ((const int*)p.in[2])[row];
  const float inv = 1.0f / powf(10000.0f, (float)(2 * i) / 64.0f);
  const float ang = (float)pos * inv;
  ((float*)(p.ws + O_COS))[(size_t)row * 32 + i] = cosf(ang);
  ((float*)(p.ws + O_SIN))[(size_t)row * 32 + i] = sinf(ang);
}

DI void norm_rows(const float* __restrict__ xin, const float* __restrict__ gn, const float* __restrict__ ada_sh, const float* __restrict__ ada_sc,
                  bf16_t* __restrict__ H) {
  const int tid_ = otid(), lane = tid_ & 63, w = tid_ >> 6;
  const int nw = gridDim.x * 4;
  for (int row0 = (blockIdx.x * 4 + w) * 8; row0 < T; row0 += nw * 8) {
    const int b = row0 / S;
    float4 v[8][4];
#pragma unroll
    for (int r = 0; r < 8; ++r)
#pragma unroll
      for (int i = 0; i < 4; ++i) v[r][i] = *(const float4*)(xin + (size_t)(row0 + r) * 1024 + (lane + 64 * i) * 4);
    float4 gk[4], sh[4];
#pragma unroll
    for (int i = 0; i < 4; ++i) {
      const int col = (lane + 64 * i) * 4;
      const float4 g = *(const float4*)(gn + col);
      const float4 sc = *(const float4*)(ada_sc + (size_t)b * 6144 + col);
      sh[i] = *(const float4*)(ada_sh + (size_t)b * 6144 + col);
      gk[i].x = g.x * (1.f + sc.x); gk[i].y = g.y * (1.f + sc.y); gk[i].z = g.z * (1.f + sc.z); gk[i].w = g.w * (1.f + sc.w);
    }
    float ss[8];
#pragma unroll
    for (int r = 0; r < 8; ++r) {
      ss[r] = 0.f;
#pragma unroll
      for (int i = 0; i < 4; ++i) ss[r] += v[r][i].x * v[r][i].x + v[r][i].y * v[r][i].y + v[r][i].z * v[r][i].z + v[r][i].w * v[r][i].w;
    }
#pragma unroll
    for (int o = 32; o >= 1; o >>= 1) {
#pragma unroll
      for (int r = 0; r < 8; ++r) ss[r] += __shfl_xor(ss[r], o);
    }
#pragma unroll
    for (int r = 0; r < 8; ++r) {
      const float rr = rsqrtf(ss[r] * (1.f / 1024.f) + 1e-6f);
#pragma unroll
      for (int i = 0; i < 4; ++i) {
        const int col = (lane + 64 * i) * 4;
        uint2 o;
        o.x = pk2(v[r][i].x * rr * gk[i].x + sh[i].x, v[r][i].y * rr * gk[i].y + sh[i].y);
        o.y = pk2(v[r][i].z * rr * gk[i].z + sh[i].z, v[r][i].w * rr * gk[i].w + sh[i].w);
        *(uint2*)(H + (size_t)(row0 + r) * 1024 + col) = o;
      }
    }
  }
}

DI void qk_epilogue(const float* st  , int m0, const float* __restrict__ gain, float scale, bf16_t* __restrict__ dst, int dstride, int dcol0,
                    const float* __restrict__ COS, const float* __restrict__ SIN) {
  const int tid = otid(), row = tid & 127, hd = tid >> 7;
  const float* sp = st + row * 132 + hd * 64;
  float ss = 0.f;
#pragma unroll 4
  for (int j = 0; j < 64; j += 4) { const float4 v = *(const float4*)(sp + j); ss += v.x * v.x + v.y * v.y + v.z * v.z + v.w * v.w; }
  const float rr = rsqrtf(ss * (1.f / 64.f) + 1e-6f);
  const size_t tok = (size_t)(m0 + row);
  bf16_t* dp = dst + tok * dstride + dcol0 + hd * 64;
#pragma unroll 2
  for (int j = 0; j < 32; j += 8) {
    float o1[8], o2[8];
#pragma unroll
    for (int q = 0; q < 8; ++q) {
      const float x1 = sp[j + q] * rr * gain[j + q], x2 = sp[j + q + 32] * rr * gain[j + q + 32];
      const float cs = COS[tok * 32 + j + q], sn = SIN[tok * 32 + j + q];
      o1[q] = (x1 * cs - x2 * sn) * scale;
      o2[q] = (x2 * cs + x1 * sn) * scale;
    }
    *(uint4*)(dp + j) = pack8(o1);
    *(uint4*)(dp + j + 32) = pack8(o2);
  }
}
DI void raw_epilogue(const float* st, int m0, bf16_t* __restrict__ dst, int dstride, int dcol0, bool sig) {
  const int tid = otid(), row = tid & 127, hd = tid >> 7;
  const float* sp = st + row * 132 + hd * 64;
  bf16_t* dp = dst + (size_t)(m0 + row) * dstride + dcol0 + hd * 64;
#pragma unroll 2
  for (int j = 0; j < 64; j += 8) {
    float o[8];
#pragma unroll
    for (int q = 0; q < 8; ++q) { const float v = sp[j + q]; o[q] = sig ? sigmoidf_(v) : v; }
    *(uint4*)(dp + j) = pack8(o);
  }
}
DI void vt_epilogue(const float* st, int m0, bf16_t* __restrict__ dst, int nheads, int head0) {
  const int tid = otid(), col = tid & 127, rh = tid >> 7;
  const int b = m0 / S, s0 = m0 % S, hd = head0 + (col >> 6), d = col & 63;
  bf16_t* dp = dst + ((size_t)(b * nheads + hd) * 64 + d) * S + s0 + rh * 64;
#pragma unroll 2
  for (int r8 = 0; r8 < 8; ++r8) {
    float o[8];
#pragma unroll
    for (int q = 0; q < 8; ++q) o[q] = st[(rh * 64 + r8 * 8 + q) * 132 + col];
    *(uint4*)(dp + r8 * 8) = pack8(o);
  }
}


DI void gemm_mainloop_big(const bf16_t* __restrict__ A, int lda, const bf16_t* __restrict__ Bt, int ldb, int K, int m0, int n0,
                          f32x16 (&acc)[4][2], char* smem) {
  bf16_t (*sa)[72] = (bf16_t (*)[72])smem;
  bf16_t (*sb)[72] = (bf16_t (*)[72])(smem + 256 * 72 * 2);
  const int tid = otid(), lane = tid & 63, w = tid >> 6, wm = w >> 1, wn = w & 1;
  const int r = lane & 31, half = lane >> 5;
  const int nk = K >> 6;
  u32x4 ra[8], rb[4];
  const bf16_t* ap = A + (size_t)(m0 + (tid >> 3)) * lda + (tid & 7) * 8;
  const bf16_t* bp = Bt + (size_t)(n0 + (tid >> 3)) * ldb + (tid & 7) * 8;
#pragma unroll
  for (int i = 0; i < 8; ++i) ra[i] = *(const u32x4*)(ap + (size_t)(32 * i) * lda);
#pragma unroll
  for (int i = 0; i < 4; ++i) rb[i] = *(const u32x4*)(bp + (size_t)(32 * i) * ldb);
  __syncthreads();
#pragma unroll
  for (int i = 0; i < 8; ++i) *(u32x4*)&sa[(tid >> 3) + 32 * i][(tid & 7) * 8] = ra[i];
#pragma unroll
  for (int i = 0; i < 4; ++i) *(u32x4*)&sb[(tid >> 3) + 32 * i][(tid & 7) * 8] = rb[i];
  __syncthreads();
  for (int kt = 0; kt < nk; ++kt) {
    if (kt + 1 < nk) {
#pragma unroll
      for (int i = 0; i < 8; ++i) ra[i] = *(const u32x4*)(ap + (size_t)(32 * i) * lda + (kt + 1) * 64);
#pragma unroll
      for (int i = 0; i < 4; ++i) rb[i] = *(const u32x4*)(bp + (size_t)(32 * i) * ldb + (kt + 1) * 64);
    }
#pragma unroll
    for (int ks = 0; ks < 4; ++ks) {
      bf16x8 af[4], bfr[2];
#pragma unroll
      for (int f = 0; f < 4; ++f) af[f] = *(const bf16x8*)&sa[wm * 128 + f * 32 + r][ks * 16 + half * 8];
#pragma unroll
      for (int f = 0; f < 2; ++f) bfr[f] = *(const bf16x8*)&sb[wn * 64 + f * 32 + r][ks * 16 + half * 8];
#pragma unroll
      for (int mf = 0; mf < 4; ++mf)
#pragma unroll
        for (int nf = 0; nf < 2; ++nf) acc[mf][nf] = MFMA32(af[mf], bfr[nf], acc[mf][nf]);
    }
    __syncthreads();
    if (kt + 1 < nk) {
#pragma unroll
      for (int i = 0; i < 8; ++i) *(u32x4*)&sa[(tid >> 3) + 32 * i][(tid & 7) * 8] = ra[i];
#pragma unroll
      for (int i = 0; i < 4; ++i) *(u32x4*)&sb[(tid >> 3) + 32 * i][(tid & 7) * 8] = rb[i];
    }
    __syncthreads();
  }
}
DI void zero_acc_big(f32x16 (&acc)[4][2]) {
#pragma unroll
  for (int a = 0; a < 4; ++a)
#pragma unroll
    for (int b = 0; b < 2; ++b)
#pragma unroll
      for (int i = 0; i < 16; ++i) acc[a][b][i] = 0.f;
}
DI void stage_half(float* st, const f32x16 (&acc)[4][2], int h, int tid) {
  const int lane = tid & 63, w = tid >> 6, wm = w >> 1, wn = w & 1, c = lane & 31, half = lane >> 5;
  if (wm == h) {
#pragma unroll
    for (int mf = 0; mf < 4; ++mf)
#pragma unroll
      for (int nf = 0; nf < 2; ++nf)
#pragma unroll
        for (int i = 0; i < 16; ++i) st[(mf * 32 + crow(i, half)) * 132 + wn * 64 + nf * 32 + c] = acc[mf][nf][i];
  }
}
DI bool gemm_coords_big(int idx, int NT, int& mt, int& nt) {
  const int x = idx & 7, q = idx >> 3, om = q >> 6, qq = q & 63;
  const int macro = om * 8 + x, Mb = macro & 7, Nb = macro >> 3;
  mt = Mb * 8 + (qq & 7); nt = Nb * 8 + (qq >> 3);
  return nt < NT;
}
DI int gemm_slots_big(int NT) { return 8 * ((NT + 7) / 8) * 64; }

DI void in_epilogue_half(const Params& p, int l, const float* st, int m0, int nt) {
  char* ws = p.ws;
  const float* COS = (const float*)(ws + O_COS);
  const float* SIN = (const float*)(ws + O_SIN);
  if (nt < 4) qk_epilogue(st, m0, p.in[8] + l * 64, 0.125f, (bf16_t*)(ws + O_QA), 512, nt * 128, COS, SIN);
  else if (nt == 4) raw_epilogue(st, m0, (bf16_t*)(ws + O_KC), 128, 0, false);
  else if (nt == 5) raw_epilogue(st, m0, (bf16_t*)(ws + O_VC), 128, 0, false);
  else if (nt == 6) qk_epilogue(st, m0, p.in[9] + l * 64, 1.f, (bf16_t*)(ws + O_KS), 128, 0, COS, SIN);
  else if (nt == 7) vt_epilogue(st, m0, (bf16_t*)(ws + O_VST), 2, 0);
  else if (nt == 8) qk_epilogue(st, m0, p.in[9] + l * 64, 1.f, (bf16_t*)(ws + O_KW), 128, 0, COS, SIN);
  else if (nt == 9) vt_epilogue(st, m0, (bf16_t*)(ws + O_VWT), 2, 0);
  else if (nt < 14) qk_epilogue(st, m0, p.in[15] + l * 64, 0.125f, (bf16_t*)(ws + O_QB), 512, (nt - 10) * 128, COS, SIN);
  else if (nt < 18) qk_epilogue(st, m0, p.in[16] + l * 64, 1.f, (bf16_t*)(ws + O_KB), 512, (nt - 14) * 128, COS, SIN);
  else if (nt < 22) vt_epilogue(st, m0, (bf16_t*)(ws + O_VBT), 8, (nt - 18) * 2);
  else if (nt < 38) raw_epilogue(st, m0, (bf16_t*)(ws + O_GBR), 2048, (nt - 22) * 128, true);
  else {
    const int tid = otid();
    if (tid < 128) {
      float* gp = (float*)(ws + O_GA) + (size_t)(m0 + tid) * 24;
#pragma unroll
      for (int j = 0; j < 24; ++j) gp[j] = sigmoidf_(st[tid * 132 + j]);
    }
  }
}
DI void gemm_in_tile_big(const Params& p, int l, int mt, int nt, char* smem) {
  char* ws = p.ws;
  f32x16 acc[4][2];
  zero_acc_big(acc);
  const int m0 = mt * 256, n0 = nt * 128;
  gemm_mainloop_big((const bf16_t*)(ws + O_H), 1024, (const bf16_t*)(ws + wdl(l) + O_WIN), 1024, 1024, m0, n0, acc, smem);
  float* st = (float*)smem;
#pragma unroll
  for (int h = 0; h < 2; ++h) {
    stage_half(st, acc, h, otid());
    __syncthreads();
    in_epilogue_half(p, l, st, m0 + h * 128, nt);
    __syncthreads();
  }
}
DI void gemm_res_tile_big(const bf16_t* A, int lda, const bf16_t* Bt, int K, const float* __restrict__ xin, float* __restrict__ xout,
                          const float* __restrict__ gate, int mt, int nt, char* smem) {
  const int m0 = mt * 256, n0 = nt * 128;
  f32x16 acc[4][2];
  zero_acc_big(acc);
  gemm_mainloop_big(A, lda, Bt, K, K, m0, n0, acc, smem);
  float* st = (float*)smem;
  const int b = m0 / S;
#pragma unroll
  for (int h = 0; h < 2; ++h) {
    const int tid = otid();
    stage_half(st, acc, h, tid);
    __syncthreads();
    const int r = tid >> 5, ch = tid & 31;
    const float4 g = *(const float4*)(gate + (size_t)b * 6144 + n0 + ch * 4);
#pragma unroll 4
    for (int ps = 0; ps < 16; ++ps) {
      const int row = ps * 8 + r;
      const float4 a = *(const float4*)(st + row * 132 + ch * 4);
      const size_t off = (size_t)(m0 + h * 128 + row) * 1024 + n0 + ch * 4;
      const float4 xi = *(const float4*)(xin + off);
      float4 o; o.x = xi.x + g.x * a.x; o.y = xi.y + g.y * a.y; o.z = xi.z + g.z * a.z; o.w = xi.w + g.w * a.w;
      *(float4*)(xout + off) = o;
    }
    __syncthreads();
  }
}
DI void gemm_ffi_tile_big(const Params& p, int l, int mt, int nt, char* smem) {
  char* ws = p.ws;
  const int m0 = mt * 256, n0 = nt * 128;
  f32x16 acc[4][2];
  zero_acc_big(acc);
  gemm_mainloop_big((const bf16_t*)(ws + O_H), 1024, (const bf16_t*)(ws + wdl(l) + O_WFFI), 1024, 1024, m0, n0, acc, smem);
  bf16_t* ACT = (bf16_t*)(ws + O_ACT);
  bf16_t (*sbt)[72] = (bf16_t (*)[72])smem;
  const int tid = otid(), lane = tid & 63, w = tid >> 6, wm = w >> 1, wn = w & 1, c = lane & 31, half = lane >> 5;
#pragma unroll
  for (int mf = 0; mf < 4; ++mf)
#pragma unroll
    for (int i = 0; i < 16; ++i) {
      const float g = acc[mf][0][i], u = acc[mf][1][i];
      const float a = g / (1.f + __expf(-g)) * u;
      sbt[wm * 128 + mf * 32 + crow(i, half)][wn * 32 + c] = (bf16_t)(pk2(a, 0.f) & 0xffff);
    }
  __syncthreads();
  const int r = tid >> 3, ch = tid & 7;
#pragma unroll
  for (int ps = 0; ps < 8; ++ps) {
    const int row = ps * 32 + r;
    *(u32x4*)(ACT + (size_t)(m0 + row) * DFF + nt * 64 + ch * 8) = *(const u32x4*)&sbt[row][ch * 8];
  }
  __syncthreads();
}
DI void gemm_up_pass_big(const bf16_t* Y, const bf16_t* W, const bf16_t* __restrict__ GBR, int gcol0, bf16_t* __restrict__ MG, bool first,
                         int mt, int nt, char* smem) {
  const int m0 = mt * 256, n0 = nt * 128;
  f32x16 acc[4][2];
  zero_acc_big(acc);
  gemm_mainloop_big(Y, 512, W, 512, 512, m0, n0, acc, smem);
  float* st = (float*)smem;
#pragma unroll
  for (int h = 0; h < 2; ++h) {
    const int tid = otid();
    stage_half(st, acc, h, tid);
    __syncthreads();
    const int r = tid >> 4, ch = tid & 15;
#pragma unroll 2
    for (int ps = 0; ps < 8; ++ps) {
      const int row = ps * 16 + r;
      const float4 a0 = *(const float4*)(st + row * 132 + ch * 8), a1 = *(const float4*)(st + row * 132 + ch * 8 + 4);
      const size_t grow = (size_t)(m0 + h * 128 + row);
      const u32x4 gv = *(const u32x4*)(GBR + grow * 2048 + gcol0 + n0 + ch * 8);
      float v[8];
      v[0] = bf_lo(gv.x) * a0.x; v[1] = bf_hi(gv.x) * a0.y; v[2] = bf_lo(gv.y) * a0.z; v[3] = bf_hi(gv.y) * a0.w;
      v[4] = bf_lo(gv.z) * a1.x; v[5] = bf_hi(gv.z) * a1.y; v[6] = bf_lo(gv.w) * a1.z; v[7] = bf_hi(gv.w) * a1.w;
      bf16_t* mp = MG + grow * 1024 + n0 + ch * 8;
      if (!first) {
        const u32x4 pv = *(const u32x4*)mp;
        v[0] += bf_lo(pv.x); v[1] += bf_hi(pv.x); v[2] += bf_lo(pv.y); v[3] += bf_hi(pv.y);
        v[4] += bf_lo(pv.z); v[5] += bf_hi(pv.z); v[6] += bf_lo(pv.w); v[7] += bf_hi(pv.w);
      }
      u32x4 ov; ov.x = pk2(v[0], v[1]); ov.y = pk2(v[2], v[3]); ov.z = pk2(v[4], v[5]); ov.w = pk2(v[6], v[7]);
      *(u32x4*)mp = ov;
    }
    __syncthreads();
  }
}

DI float gelu_tanh(float x) {
  const float u = 0.7978845608028654f * (x + 0.044715f * x * x * x);
  const float e = __expf(2.f * u);
  const float th = 1.f - 2.f / (e + 1.f);
  return 0.5f * x * (1.f + th);
}

DI void cmp_tile(const Params& p, int l, int tile, char* smem) {
  char* ws = p.ws;
  const int kv = tile & 1, bg = (tile >> 1) & 3, nb = tile >> 3, b = bg >> 1, g = bg & 1;
  const int tid = otid(), lane = tid & 63, w = tid >> 6, r = lane & 31, half = lane >> 5;
  const bf16_t* src = (const bf16_t*)(ws + (kv ? O_VC : O_KC));
  const bf16_t* W1T = (const bf16_t*)(ws + wdl(l) + (kv ? O_CVW1 : O_CKW1));
  const bf16_t* W2T = (const bf16_t*)(ws + wdl(l) + (kv ? O_CVW2 : O_CKW2));
  const float* pe = p.in[10] + (size_t)l * 32 * 64;
  bf16_t (*hid)[136] = (bf16_t (*)[136])smem;
  float (*outf)[68] = (float (*)[68])(smem + 8704);
  int n = nb * 32 + r; if (n > 510) n = 510;
  const bf16_t* arow = src + ((size_t)b * S + 16 * n) * 128 + g * 64 + half * 8;
  float (*part)[32][128] = (float (*)[32][128])smem;
  f32x16 acc[4];
#pragma unroll
  for (int nf = 0; nf < 4; ++nf)
#pragma unroll
    for (int i = 0; i < 16; ++i) acc[nf][i] = 0.f;
  const bf16_t* brow = W1T + (size_t)r * 2048 + half * 8;
#pragma unroll 2
  for (int t8 = 0; t8 < 8; ++t8) {
    const int tl = 8 * w + t8;
#pragma unroll
    for (int dk = 0; dk < 4; ++dk) {
      const uint4 av = *(const uint4*)(arow + (size_t)tl * 128 + dk * 16);
      const float4 p0 = *(const float4*)(pe + tl * 64 + dk * 16 + half * 8);
      const float4 p1 = *(const float4*)(pe + tl * 64 + dk * 16 + half * 8 + 4);
      uint4 a2;
      a2.x = pk2(bf_lo(av.x) + p0.x, bf_hi(av.x) + p0.y);
      a2.y = pk2(bf_lo(av.y) + p0.z, bf_hi(av.y) + p0.w);
      a2.z = pk2(bf_lo(av.z) + p1.x, bf_hi(av.z) + p1.y);
      a2.w = pk2(bf_lo(av.w) + p1.z, bf_hi(av.w) + p1.w);
      const bf16x8 a8 = __builtin_bit_cast(bf16x8, a2);
#pragma unroll
      for (int nf = 0; nf < 4; ++nf) {
        const bf16x8 bv = *(const bf16x8*)(brow + (size_t)(nf * 32) * 2048 + tl * 64 + dk * 16);
        acc[nf] = MFMA32(a8, bv, acc[nf]);
      }
    }
  }
  __syncthreads();
#pragma unroll
  for (int nf = 0; nf < 4; ++nf)
#pragma unroll
    for (int i = 0; i < 16; ++i) part[w][crow(i, half)][nf * 32 + r] = acc[nf][i];
  __syncthreads();
  float hv[16];
#pragma unroll
  for (int e = 0; e < 16; ++e) {
    const int idx = tid + 256 * e, row = idx >> 7, col = idx & 127;
    hv[e] = gelu_tanh((part[0][row][col] + part[1][row][col]) + (part[2][row][col] + part[3][row][col]));
  }
  __syncthreads();
#pragma unroll
  for (int e = 0; e < 16; ++e) {
    const int idx = tid + 256 * e, row = idx >> 7, col = idx & 127;
    hid[row][col] = (bf16_t)(pk2(hv[e], 0.f) & 0xffff);
  }
  __syncthreads();
  if (w < 2) {
    f32x16 a2;
#pragma unroll
    for (int i = 0; i < 16; ++i) a2[i] = 0.f;
#pragma unroll
    for (int ks = 0; ks < 8; ++ks) {
      const bf16x8 av = *(const bf16x8*)&hid[r][ks * 16 + half * 8];
      const bf16x8 bv = *(const bf16x8*)(W2T + (size_t)(32 * w + r) * 128 + ks * 16 + half * 8);
      a2 = MFMA32(av, bv, a2);
    }
#pragma unroll
    for (int i = 0; i < 16; ++i) outf[crow(i, half)][32 * w + r] = a2[i];
  }
  __syncthreads();
  if (kv == 0) {
    const int row = tid >> 3, part = tid & 7, nn = nb * 32 + row;
    float ss = 0.f;
#pragma unroll
    for (int q = 0; q < 8; ++q) { const float v = outf[row][part * 8 + q]; ss += v * v; }
    ss += __shfl_xor(ss, 1); ss += __shfl_xor(ss, 2); ss += __shfl_xor(ss, 4);
    const float rr = rsqrtf(ss * (1.f / 64.f) + 1e-6f);
    const int j0 = (part & 3) * 8, hi = part >> 2;
    const float* gain = p.in[9] + l * 64;
    const int nc = nn > 510 ? 510 : nn;
    const size_t prow = (size_t)b * S + 16 * nc + 31;
    const float* COS = (const float*)(ws + O_COS) + prow * 32;
    const float* SIN = (const float*)(ws + O_SIN) + prow * 32;
    float o[8];
#pragma unroll
    for (int q = 0; q < 8; ++q) {
      const float x1 = outf[row][j0 + q] * rr * gain[j0 + q], x2 = outf[row][j0 + q + 32] * rr * gain[j0 + q + 32];
      const float cs = COS[j0 + q], sn = SIN[j0 + q];
      const float v = hi ? (x2 * cs + x1 * sn) : (x1 * cs - x2 * sn);
      o[q] = nn > 510 ? 0.f : v;
    }
    *(uint4*)((bf16_t*)(ws + O_KCMP) + ((size_t)(b * 2 + g) * 512 + nn) * 64 + hi * 32 + j0) = pack8(o);
  } else {
    const int d = tid & 63, ng = tid >> 6;
    float o[8];
#pragma unroll
    for (int q = 0; q < 8; ++q) { const int nn = nb * 32 + ng * 8 + q; o[q] = nn > 510 ? 0.f : outf[ng * 8 + q][d]; }
    *(uint4*)((bf16_t*)(ws + O_VCMPT) + ((size_t)(b * 2 + g) * 64 + d) * 512 + nb * 32 + ng * 8) = pack8(o);
  }
  __syncthreads();
}

DI void kmean_task(const Params& p, int task, char* smem) {
  char* ws = p.ws;
  float* red = (float*)smem;
  const int tid = otid(), cq = task & 3, blk = (task >> 2) & 31, b = task >> 7;
  const int cp = tid & 63, tq = tid >> 6;
  const bf16_t* kp = (const bf16_t*)(ws + O_KB) + ((size_t)b * S + blk * 256 + tq * 64) * 512 + cq * 128 + cp * 2;
  float a0 = 0.f, a1 = 0.f;
#pragma unroll 8
  for (int k = 0; k < 64; ++k) { const unsigned u = *(const unsigned*)(kp + (size_t)k * 512); a0 += bf_lo(u); a1 += bf_hi(u); }
  red[tq * 128 + cp * 2] = a0; red[tq * 128 + cp * 2 + 1] = a1;
  __syncthreads();
  if (tid < 128) {
    const float s = (red[tid] + red[128 + tid] + red[256 + tid] + red[384 + tid]) * (1.f / 256.f);
    const int col = cq * 128 + tid, h = col >> 6, d = col & 63;
    ((bf16_t*)(ws + O_KMEAN))[((size_t)(b * 8 + h) * 32 + blk) * 64 + d] = (bf16_t)(pk2(s, 0.f) & 0xffff);
  }
  __syncthreads();
}

struct AttnSmem {
  bf16_t k[2][64][72];
  bf16_t vt[2][64][72];
  float imp[32][136];
  unsigned selmask[32][4];
};
static_assert(sizeof(AttnSmem) <= SMEM_BYTES, "smem");

DI void ld_tile(int tid, const bf16_t* __restrict__ kp, int kstride, const bf16_t* __restrict__ vp, int vstride, u32x4 (&r)[4]) {
#pragma unroll
  for (int i = 0; i < 2; ++i) {
    const int id = tid + 256 * i, row = id >> 3, c = id & 7;
    r[i] = *(const u32x4*)(kp + (size_t)row * kstride + c * 8);
    r[2 + i] = *(const u32x4*)(vp + (size_t)row * vstride + c * 8);
  }
}
DI void st_tile(int tid, AttnSmem& sm, int buf, const u32x4 (&r)[4]) {
#pragma unroll
  for (int i = 0; i < 2; ++i) {
    const int id = tid + 256 * i, row = id >> 3, c = id & 7;
    *(u32x4*)&sm.k[buf][row][c * 8] = r[i];
    *(u32x4*)&sm.vt[buf][row][c * 8] = r[2 + i];
  }
}

template <class Body>
DI void kv_loop(int tid, AttnSmem& sm, const bf16_t* kp, int kstride, const bf16_t* vp, int vstride, int tlo, int thi, Body body) {
  const int n = thi - tlo;
  if (n <= 0) return;
  u32x4 r0[4], r1[4];
  ld_tile(tid, kp + (size_t)tlo * 64 * kstride, kstride, vp + (size_t)tlo * 64, vstride, r0);
  if (n > 1) ld_tile(tid, kp + (size_t)(tlo + 1) * 64 * kstride, kstride, vp + (size_t)(tlo + 1) * 64, vstride, r1);
  __syncthreads();
  st_tile(tid, sm, 0, r0);
  __syncthreads();
  for (int i = 0; i < n; i += 2) {
    if (i + 2 < n) ld_tile(tid, kp + (size_t)(tlo + i + 2) * 64 * kstride, kstride, vp + (size_t)(tlo + i + 2) * 64, vstride, r0);
    body(tlo + i, 0);
    if (i + 1 < n) st_tile(tid, sm, 1, r1);
    __syncthreads();
    if (i + 1 >= n) break;
    if (i + 3 < n) ld_tile(tid, kp + (size_t)(tlo + i + 3) * 64 * kstride, kstride, vp + (size_t)(tlo + i + 3) * 64, vstride, r1);
    body(tlo + i + 1, 1);
    if (i + 2 < n) st_tile(tid, sm, 0, r0);
    __syncthreads();
  }
}

DI void qk_scores(int lane, const bf16_t (*sk)[72], int kk, const bf16x8 (&q)[4], f32x16& s) {
  const int r = lane & 31, half = lane >> 5;
  const int pr = (r & 0x13) | ((r & 4) << 1) | ((r & 8) >> 1);
#pragma unroll
  for (int i = 0; i < 16; ++i) s[i] = 0.f;
#pragma unroll
  for (int ks = 0; ks < 4; ++ks) {
    const bf16x8 a = *(const bf16x8*)&sk[kk * 32 + pr][ks * 16 + half * 8];
    s = MFMA32(a, q[ks], s);
  }
}

DI float max16(const f32x16& s) {
  float m = s[0];
#pragma unroll
  for (int j = 1; j < 16; ++j) m = fmaxf(m, s[j]);
  return m;
}
DI f32x2 mk2(float a, float b) { f32x2 r = {a, b}; return r; }
template <bool ELEM>
DI void attn_step64(int lane, const bf16_t (*sk)[72], const bf16_t (*svt)[72], const bf16x8 (&q)[4], f32x16 (&o)[2], float& m, float& l,
                    bool lane_on, int key0, int lo, int hi) {
  const int r = lane & 31, half = lane >> 5;
  const int pr = (r & 0x13) | ((r & 4) << 1) | ((r & 8) >> 1);
  f32x16 s0, s1;
#pragma unroll
  for (int i = 0; i < 16; ++i) { s0[i] = 0.f; s1[i] = 0.f; }
#pragma unroll
  for (int ks = 0; ks < 4; ++ks) {
    const bf16x8 a0 = *(const bf16x8*)&sk[pr][ks * 16 + half * 8];
    const bf16x8 a1 = *(const bf16x8*)&sk[32 + pr][ks * 16 + half * 8];
    s0 = MFMA32(a0, q[ks], s0);
    s1 = MFMA32(a1, q[ks], s1);
  }
  if (ELEM) {
#pragma unroll
    for (int i = 0; i < 16; ++i) {
      const int key = key0 + (i & 7) + 8 * half + 16 * (i >> 3);
      const bool ok0 = lane_on && key >= lo && key <= hi;
      const bool ok1 = lane_on && (key + 32) >= lo && (key + 32) <= hi;
      s0[i] = ok0 ? s0[i] : NEGF;
      s1[i] = ok1 ? s1[i] : NEGF;
    }
  }
  float mx = fmaxf(max16(s0), max16(s1));
  if (!ELEM && !lane_on) mx = NEGF;
  mx = xhalf_max(mx);
  const bool upd = (mx - m) * L2E > 8.f;
  if (__any(upd)) {
    const float mnew = upd ? mx : m;
    const float alpha = __builtin_amdgcn_exp2f((m - mnew) * L2E);
    l *= alpha;
    m = mnew;
    const f32x2 al2 = mk2(alpha, alpha);
#pragma unroll
    for (int mt = 0; mt < 2; ++mt)
#pragma unroll
      for (int i = 0; i < 16; i += 2) { f32x2 v = mk2(o[mt][i], o[mt][i + 1]); v = v * al2; o[mt][i] = v.x; o[mt][i + 1] = v.y; }
  }
  float mb = (m < -1e29f) ? 0.f : m * L2E;
  if (!ELEM && !lane_on) mb = __builtin_inff();
  const f32x2 l2e2 = mk2(L2E, L2E), nmb2 = mk2(-mb, -mb);
  f32x2 sum0 = mk2(0.f, 0.f), sum1 = mk2(0.f, 0.f);
#pragma unroll
  for (int i = 0; i < 16; i += 2) {
    f32x2 v0 = __builtin_elementwise_fma(mk2(s0[i], s0[i + 1]), l2e2, nmb2);
    f32x2 v1 = __builtin_elementwise_fma(mk2(s1[i], s1[i + 1]), l2e2, nmb2);
    v0.x = __builtin_amdgcn_exp2f(v0.x); v0.y = __builtin_amdgcn_exp2f(v0.y);
    v1.x = __builtin_amdgcn_exp2f(v1.x); v1.y = __builtin_amdgcn_exp2f(v1.y);
    sum0 += v0; sum1 += v1;
    s0[i] = v0.x; s0[i + 1] = v0.y; s1[i] = v1.x; s1[i + 1] = v1.y;
  }
  sum0 += sum1;
  l += sum0.x + sum0.y;
#pragma unroll
  for (int j = 0; j < 4; ++j) {
    uint4 pu;
    if (j < 2) { pu.x = pk2(s0[8 * j], s0[8 * j + 1]); pu.y = pk2(s0[8 * j + 2], s0[8 * j + 3]); pu.z = pk2(s0[8 * j + 4], s0[8 * j + 5]); pu.w = pk2(s0[8 * j + 6], s0[8 * j + 7]); }
    else { const int jj = j - 2; pu.x = pk2(s1[8 * jj], s1[8 * jj + 1]); pu.y = pk2(s1[8 * jj + 2], s1[8 * jj + 3]); pu.z = pk2(s1[8 * jj + 4], s1[8 * jj + 5]); pu.w = pk2(s1[8 * jj + 6], s1[8 * jj + 7]); }
    const bf16x8 pb = __builtin_bit_cast(bf16x8, pu);
#pragma unroll
    for (int mt = 0; mt < 2; ++mt) {
      const bf16x8 a = *(const bf16x8*)&svt[mt * 32 + r][j * 16 + half * 8];
      o[mt] = MFMA32(a, pb, o[mt]);
    }
  }
}

DI void zero_o(f32x16 (&o)[2]) {
#pragma unroll
  for (int a = 0; a < 2; ++a)
#pragma unroll
    for (int i = 0; i < 16; ++i) o[a][i] = 0.f;
}

DI void nsa_tile(const Params& p, int rank, char* smem) {
  char* ws = p.ws;
  AttnSmem& sm = *(AttnSmem*)smem;
  const int bg = rank & 3, b = bg >> 1, g = bg & 1, t0 = (255 - (rank >> 2)) * 32;
  const int tid = otid(), lane = tid & 63, w = tid >> 6, c = lane & 31, half = lane >> 5;
  const int tokl = w * 8 + (c >> 2), hh = c & 3, t = t0 + tokl, head = g * 4 + hh;
  __syncthreads();
  for (int i = tid; i < 32 * 136; i += 256) (&sm.imp[0][0])[i] = 0.f;
  bf16x8 q[4];
  {
    const bf16_t* qp = (const bf16_t*)(ws + O_QA) + ((size_t)b * S + t) * 512 + head * 64 + half * 8;
#pragma unroll
    for (int ks = 0; ks < 4; ++ks) q[ks] = *(const bf16x8*)(qp + ks * 16);
  }
  const float* gap = (const float*)(ws + O_GA) + ((size_t)b * S + t) * 24 + head * 3;
  const float g0 = gap[0], g1 = gap[1], g2 = gap[2];
  f32x16 y[2];
  zero_o(y);

  {
    const int nlim = (t - 31) >> 4;
    const int ntile = ((t0 >> 4) >> 6) + 1;
    const bf16_t* kp = (const bf16_t*)(ws + O_KCMP) + (size_t)(b * 2 + g) * 512 * 64;
    const bf16_t* vp = (const bf16_t*)(ws + O_VCMPT) + (size_t)(b * 2 + g) * 64 * 512;
    f32x16 o[2];
    zero_o(o);
    float m = NEGF, l = 0.f;
    kv_loop(tid, sm, kp, 64, vp, 512, 0, ntile, [&](int it, int buf) {
      attn_step64<true>(lane, sm.k[buf], sm.vt[buf], q, o, m, l, true, it * 64, 0, nlim);
    });
    const float lt = xhalf_sum(l);
    const float inv = lt > 0.f ? 1.f / lt : 0.f;
    const float sc = g0 * inv;
#pragma unroll
    for (int mt = 0; mt < 2; ++mt)
#pragma unroll
      for (int i = 0; i < 16; ++i) y[mt][i] += sc * o[mt][i];
    const float mbl = (m < -1e29f) ? 0.f : m * L2E;
    kv_loop(tid, sm, kp, 64, vp, 512, 0, ntile, [&](int it, int buf) {
#pragma unroll
      for (int kk = 0; kk < 2; ++kk) {
        f32x16 s;
        qk_scores(lane, sm.k[buf], kk, q, s);
        float pn[16];
#pragma unroll
        for (int i = 0; i < 16; ++i) {
          const int n = it * 64 + kk * 32 + (i & 7) + 8 * half + 16 * (i >> 3);
          const float e = __builtin_amdgcn_exp2f(fmaf(s[i], L2E, -mbl)) * inv;
          pn[i] = (n <= nlim) ? e : 0.f;
        }
#pragma unroll
        for (int j = 0; j < 2; ++j) {
          float v0 = (pn[8 * j] + pn[8 * j + 1]) + (pn[8 * j + 2] + pn[8 * j + 3]);
          float v1 = (pn[8 * j + 4] + pn[8 * j + 5]) + (pn[8 * j + 6] + pn[8 * j + 7]) + pn[8 * j + 3];
          float v2 = pn[8 * j + 7];
          v0 = quad_sum(v0); v1 = quad_sum(v1); v2 = quad_sum(v2);
          if (hh == 0) {
            const int Ja = (it * 64 + kk * 32 + 16 * j + 8 * half) >> 2;
            if (Ja < 128) atomicAdd(&sm.imp[tokl][Ja], v0);
            if (Ja + 1 < 128) atomicAdd(&sm.imp[tokl][Ja + 1], v1);
            if (Ja + 2 < 128) atomicAdd(&sm.imp[tokl][Ja + 2], v2);
          }
        }
      }
    });
  }
  __syncthreads();
  {
    const int tk = w * 8 + (lane >> 3), sub = lane & 7, tt = t0 + tk, jown = tt >> 6;
    unsigned key[16];
#pragma unroll
    for (int i = 0; i < 16; ++i) {
      const int J = i * 8 + sub;
      float v = sm.imp[tk][J];
      if (J == 0 || J == jown) v = 1e4f;
      if (J * 64 > tt) v = NEGF;
      const unsigned u = __float_as_uint(v);
      const unsigned ok = (u & 0x80000000u) ? ~u : (u | 0x80000000u);
      key[i] = (ok & ~127u) | (unsigned)(127 - J);
    }
    unsigned Tk = 0;
    for (int bit = 31; bit >= 0; --bit) {
      const unsigned cand = Tk | (1u << bit);
      int cnt = 0;
#pragma unroll
      for (int i = 0; i < 16; ++i) cnt += (key[i] >= cand) ? 1 : 0;
      cnt = oct_sum(cnt);
      if (cnt >= 16) Tk = cand;
    }
    unsigned wb[4] = {0u, 0u, 0u, 0u};
#pragma unroll
    for (int i = 0; i < 16; ++i) if (key[i] >= Tk) wb[i >> 2] |= 1u << (8 * (i & 3) + sub);
#pragma unroll
    for (int k = 0; k < 4; ++k) wb[k] = oct_or(wb[k]);
    if (sub == 0) { sm.selmask[tk][0] = wb[0]; sm.selmask[tk][1] = wb[1]; sm.selmask[tk][2] = wb[2]; sm.selmask[tk][3] = wb[3]; }
  }
  __syncthreads();
  {
    const int jown = t0 >> 6;
    const bf16_t* kp = (const bf16_t*)(ws + O_KS) + (size_t)b * S * 128 + g * 64;
    const bf16_t* vp = (const bf16_t*)(ws + O_VST) + (size_t)(b * 2 + g) * 64 * S;
    f32x16 o[2];
    zero_o(o);
    float m = NEGF, l = 0.f;
    kv_loop(tid, sm, kp, 128, vp, S, 0, jown, [&](int it, int buf) {
      const bool on = (sm.selmask[tokl][it >> 5] >> (it & 31)) & 1u;
      if (__any(on)) attn_step64<false>(lane, sm.k[buf], sm.vt[buf], q, o, m, l, on, it * 64, 0, t);
    });
    kv_loop(tid, sm, kp, 128, vp, S, jown, jown + 1, [&](int it, int buf) {
      const bool on = (sm.selmask[tokl][it >> 5] >> (it & 31)) & 1u;
      attn_step64<true>(lane, sm.k[buf], sm.vt[buf], q, o, m, l, on, it * 64, 0, t);
    });
    const float lt = xhalf_sum(l);
    const float sc = g1 * (lt > 0.f ? 1.f / lt : 0.f);
#pragma unroll
    for (int mt = 0; mt < 2; ++mt)
#pragma unroll
      for (int i = 0; i < 16; ++i) y[mt][i] += sc * o[mt][i];
  }
  {
    const int tl0 = (t0 - 511) < 0 ? 0 : ((t0 - 511) >> 6);
    const bf16_t* kp = (const bf16_t*)(ws + O_KW) + (size_t)b * S * 128 + g * 64;
    const bf16_t* vp = (const bf16_t*)(ws + O_VWT) + (size_t)(b * 2 + g) * 64 * S;
    f32x16 o[2];
    zero_o(o);
    float m = NEGF, l = 0.f;
    kv_loop(tid, sm, kp, 128, vp, S, tl0, (t0 >> 6) + 1, [&](int it, int buf) {
      attn_step64<true>(lane, sm.k[buf], sm.vt[buf], q, o, m, l, true, it * 64, t - 511, t);
    });
    const float lt = xhalf_sum(l);
    const float sc = g2 * (lt > 0.f ? 1.f / lt : 0.f);
#pragma unroll
    for (int mt = 0; mt < 2; ++mt)
#pragma unroll
      for (int i = 0; i < 16; ++i) y[mt][i] += sc * o[mt][i];
  }
  {
    bf16_t* yp = (bf16_t*)(ws + O_YA) + ((size_t)b * S + t) * 512 + head * 64;
#pragma unroll
    for (int mt = 0; mt < 2; ++mt)
#pragma unroll
      for (int g4 = 0; g4 < 4; ++g4) {
        uint2 u; u.x = pk2(y[mt][4 * g4], y[mt][4 * g4 + 1]); u.y = pk2(y[mt][4 * g4 + 2], y[mt][4 * g4 + 3]);
        *(uint2*)(yp + 32 * mt + 8 * g4 + 4 * half) = u;
      }
  }
}

DI void moba_tile(const Params& p, int rank, char* smem) {
  char* ws = p.ws;
  AttnSmem& sm = *(AttnSmem*)smem;
  const int bh = rank & 15, b = bh >> 3, h = bh & 7, s0 = (63 - (rank >> 4)) * 128, own = s0 >> 8;
  const int tid = otid(), lane = tid & 63, w = tid >> 6, c = lane & 31, half = lane >> 5;
  const int t = s0 + w * 32 + c;
  bf16x8 q[4];
  {
    const bf16_t* qp = (const bf16_t*)(ws + O_QB) + ((size_t)b * S + t) * 512 + h * 64 + half * 8;
#pragma unroll
    for (int ks = 0; ks < 4; ++ks) q[ks] = *(const bf16x8*)(qp + ks * 16);
  }
  unsigned selbits = 0;
  if (own > 0) {
    f32x16 s;
#pragma unroll
    for (int i = 0; i < 16; ++i) s[i] = 0.f;
    const bf16_t* km = (const bf16_t*)(ws + O_KMEAN) + ((size_t)(b * 8 + h) * 32 + c) * 64 + half * 8;
#pragma unroll
    for (int ks = 0; ks < 4; ++ks) { const bf16x8 a = *(const bf16x8*)(km + ks * 16); s = MFMA32(a, q[ks], s); }
    unsigned key[16];
#pragma unroll
    for (int i = 0; i < 16; ++i) {
      const int blk = crow(i, half);
      const unsigned u = __float_as_uint(s[i]);
      const unsigned ok = (u & 0x80000000u) ? ~u : (u | 0x80000000u);
      key[i] = blk < own ? ((ok & ~31u) | (unsigned)(31 - blk)) : 0u;
    }
#pragma unroll
    for (int rnd = 0; rnd < 3; ++rnd) {
      unsigned mx = 0;
#pragma unroll
      for (int i = 0; i < 16; ++i) mx = key[i] > mx ? key[i] : mx;
      const unsigned ox = (unsigned)__shfl_xor((int)mx, 32);
      const unsigned win = mx > ox ? mx : ox;
      if (win != 0u) selbits |= 1u << (31 - (win & 31u));
#pragma unroll
      for (int i = 0; i < 16; ++i) key[i] = (key[i] == win) ? 0u : key[i];
    }
  }
  const bf16_t* kp = (const bf16_t*)(ws + O_KB) + (size_t)b * S * 512 + h * 64;
  const bf16_t* vp = (const bf16_t*)(ws + O_VBT) + (size_t)(b * 8 + h) * 64 * S;
  f32x16 o[2];
  zero_o(o);
  float m = NEGF, l = 0.f;
  const int tq_hi = s0 + w * 32 + 31;
  kv_loop(tid, sm, kp, 512, vp, S, 0, own * 4, [&](int it, int buf) {
    const bool on = (selbits >> (it >> 2)) & 1u;
    if (__any(on)) attn_step64<false>(lane, sm.k[buf], sm.vt[buf], q, o, m, l, on, it * 64, 0, t);
  });
  kv_loop(tid, sm, kp, 512, vp, S, own * 4, ((s0 + 127) >> 6) + 1, [&](int it, int buf) {
    if (it * 64 <= tq_hi) attn_step64<true>(lane, sm.k[buf], sm.vt[buf], q, o, m, l, true, it * 64, 0, t);
  });
  const float lt = xhalf_sum(l);
  const float inv = lt > 0.f ? 1.f / lt : 0.f;
  bf16_t* yp = (bf16_t*)(ws + O_YB) + ((size_t)b * S + t) * 512 + h * 64;
#pragma unroll
  for (int mt = 0; mt < 2; ++mt)
#pragma unroll
    for (int g4 = 0; g4 < 4; ++g4) {
      uint2 u; u.x = pk2(o[mt][4 * g4] * inv, o[mt][4 * g4 + 1] * inv); u.y = pk2(o[mt][4 * g4 + 2] * inv, o[mt][4 * g4 + 3] * inv);
      *(uint2*)(yp + 32 * mt + 8 * g4 + 4 * half) = u;
    }
}


#define XB_TMO      128
#define XB_XCNT(j)  (256  + 64 * (j))
#define XB_XSUB(j)  (1280 + 64 * (j))
#define XB_XGEN(j)  (2304 + 64 * (j))
#define XB_TOP      3328
#define XB_TOPGEN   3392
#define XCD_BAR_WORDS 3456
#define XB_SPIN_CAP (1u << 20)
#define LAS __attribute__((address_space(3)))
DI unsigned xb_ld(unsigned* p)              { return __hip_atomic_load(p, __ATOMIC_RELAXED, __HIP_MEMORY_SCOPE_AGENT); }
DI unsigned xb_add(unsigned* p, unsigned v) { return __hip_atomic_fetch_add(p, v, __ATOMIC_RELAXED, __HIP_MEMORY_SCOPE_AGENT); }
DI unsigned xb_xcc_id() { return (unsigned)__builtin_amdgcn_s_getreg((3 << 11) | 20) & 0xFu; }
#define XB_SPIN(cond, bar) do { unsigned _sp = 0; while (cond) { __builtin_amdgcn_s_sleep(1); \
    if ((++_sp & 255u) == 0u) { if (xb_ld(&(bar)[XB_TMO])) break; if (_sp > XB_SPIN_CAP) { atomicAdd(&(bar)[XB_TMO], 1u); break; } } } } while (0)
struct XcdBarrier { unsigned* bar; unsigned x; volatile LAS unsigned* st; };
DI XcdBarrier xcd_barrier_post(unsigned* bar, volatile LAS unsigned* st) {
  XcdBarrier b; b.bar = bar; b.x = xb_xcc_id(); b.st = st;
  if (threadIdx.x == 0) (void)xb_add(&bar[XB_XCNT(b.x)], 1u);
  return b;
}
DI void xcd_barrier_complete(unsigned* bar, unsigned x, unsigned& nloc, unsigned& nx) {
  const unsigned G = gridDim.x * gridDim.y * gridDim.z;
  unsigned sum, cnt, mine, sp = 0u;
  for (;;) {
    sum = 0u; cnt = 0u; mine = 0u;
#pragma unroll
    for (unsigned j = 0; j < 16; ++j) { const unsigned c = xb_ld(&bar[XB_XCNT(j)]); sum += c; cnt += (c > 0u) ? 1u : 0u; mine = (j == x) ? c : mine; }
    if (sum == G) break;
    __builtin_amdgcn_s_sleep(1);
    if ((++sp & 255u) == 0u) { if (xb_ld(&bar[XB_TMO])) break; if (sp > XB_SPIN_CAP) { atomicAdd(&bar[XB_TMO], 1u); break; } }
  }
  nloc = mine > 0u ? mine : 1u; nx = cnt > 0u ? cnt : 1u;
}
DI void xcd_barrier(const XcdBarrier& b) {
  asm volatile("s_waitcnt vmcnt(0)" ::: "memory");
  __syncthreads();
  if (threadIdx.x == 0) {
    unsigned* bar = b.bar;
    __builtin_amdgcn_s_waitcnt(0);
    unsigned nloc = b.st[0], nx = b.st[1];
    if (nloc == 0u) { xcd_barrier_complete(bar, b.x, nloc, nx); b.st[0] = nloc; b.st[1] = nx; }
    const unsigned old = xb_add(&bar[XB_XSUB(b.x)], 1u);
    const unsigned gen = old / nloc;
    if (old + 1u == (gen + 1u) * nloc) {
      __builtin_amdgcn_fence(__ATOMIC_RELEASE, "agent");
      asm volatile("s_waitcnt vmcnt(0)" ::: "memory");
      const unsigned og = xb_add(&bar[XB_TOP], 1u);
      const unsigned tg = og / nx;
      if (og + 1u == (tg + 1u) * nx) xb_add(&bar[XB_TOPGEN], 1u);
      else XB_SPIN(xb_ld(&bar[XB_TOPGEN]) == tg, bar);
      __builtin_amdgcn_fence(__ATOMIC_ACQUIRE, "agent");
      xb_add(&bar[XB_XGEN(b.x)], 1u);
      asm volatile("s_waitcnt vmcnt(0)" ::: "memory");
    } else {
      XB_SPIN(xb_ld(&bar[XB_XGEN(b.x)]) == gen, bar);
      __builtin_amdgcn_fence(__ATOMIC_ACQUIRE, "agent");
      asm volatile("s_waitcnt vmcnt(0)" ::: "memory");
    }
  }
  __syncthreads();
}

__global__ void __launch_bounds__(256, 2) fwd_megakernel(Params p) {
  __shared__ __attribute__((aligned(16))) char smem[SMEM_BYTES];
  __shared__ uint4 xb_words;
  __shared__ int s_tile;
  char* ws = p.ws;
  if (ws == nullptr) { cg::grid_group grid = cg::this_grid(); grid.sync(); }
  if (threadIdx.x == 0) xb_words = make_uint4(0u, 0u, 0u, 0u);
  __syncthreads();
  const XcdBarrier xb = xcd_barrier_post((unsigned*)(ws + O_BAR), (volatile LAS unsigned*)&xb_words);
  const int G = gridDim.x, bid = blockIdx.x;
  const float* ADA = (const float*)(ws + O_ADA);
  float* X = (float*)(ws + O_X);

  for (int l = 0; l < NL; ++l) {
    if (l == 0) {
      for (int task = bid; task < CONV_TASKS + 384 + 2048; task += G) {
        if (task < CONV_TASKS) conv_task(p, 0, task, smem);
        else if (task < CONV_TASKS + 384) ada_task(p, task - CONV_TASKS, smem);
        else rope_task(p, task - CONV_TASKS - 384);
      }
      xcd_barrier(xb);
    }
    const float* ada_l = ADA + (size_t)l * 2 * 6144;
    const float* xin = (l == 0) ? p.in[0] : X;
    norm_rows(xin, p.in[5] + l * 1024, ada_l + 0, ada_l + 1024, (bf16_t*)(ws + O_H));
    xcd_barrier(xb);
    for (int idx = bid; idx < gemm_slots_big(39); idx += G) { int mt, nt; if (gemm_coords_big(idx, 39, mt, nt)) gemm_in_tile_big(p, l, mt, nt, smem); }
    xcd_barrier(xb);
    for (int task = bid; task < 128 + 256; task += G) {
      if (task < 128) cmp_tile(p, l, task, smem); else kmean_task(p, task - 128, smem);
    }
    xcd_barrier(xb);
    {
      unsigned* qctr = (unsigned*)(ws + O_BAR + 14336) + l * 16;
      for (;;) {
        __syncthreads();
        if (threadIdx.x == 0) s_tile = (int)atomicAdd(qctr, 1u);
        __syncthreads();
        const int rk = s_tile;
        const int nconv = (l + 1 < NL) ? CONV_TASKS : 0;
        if (rk >= 2048 + nconv) break;
        if (rk < 1024) nsa_tile(p, rk, smem);
        else if (rk < 1024 + nconv) conv_task(p, l + 1, rk - 1024, smem);
        else moba_tile(p, rk - 1024 - nconv, smem);
      }
      xcd_barrier(xb);
    }
    for (int idx = bid; idx < gemm_slots_big(8); idx += G) {
      int mt, nt;
      if (gemm_coords_big(idx, 8, mt, nt)) {
        gemm_up_pass_big((const bf16_t*)(ws + O_YA), (const bf16_t*)(ws + wdl(l) + O_WUPA), (const bf16_t*)(ws + O_GBR), 0, (bf16_t*)(ws + O_H), true, mt, nt, smem);
        gemm_up_pass_big((const bf16_t*)(ws + O_YB), (const bf16_t*)(ws + wdl(l) + O_WUPB), (const bf16_t*)(ws + O_GBR), 1024, (bf16_t*)(ws + O_H), false, mt, nt, smem);
      }
    }
    xcd_barrier(xb);
    for (int idx = bid; idx < gemm_slots_big(8); idx += G) {
      int mt, nt;
      if (gemm_coords_big(idx, 8, mt, nt)) gemm_res_tile_big((const bf16_t*)(ws + O_H), 1024, (const bf16_t*)(ws + wdl(l) + O_WOUT), 1024, xin, X, ada_l + 2048, mt, nt, smem);
    }
    xcd_barrier(xb);
    norm_rows(X, p.in[6] + l * 1024, ada_l + 3072, ada_l + 4096, (bf16_t*)(ws + O_H));
    xcd_barrier(xb);
    for (int idx = bid; idx < gemm_slots_big(44); idx += G) { int mt, nt; if (gemm_coords_big(idx, 44, mt, nt)) gemm_ffi_tile_big(p, l, mt, nt, smem); }
    xcd_barrier(xb);
    {
      float* xo = (l == NL - 1) ? p.out : X;
      for (int idx = bid; idx < gemm_slots_big(8); idx += G) {
        int mt, nt;
        if (gemm_coords_big(idx, 8, mt, nt)) gemm_res_tile_big((const bf16_t*)(ws + O_ACT), DFF, (const bf16_t*)(ws + wdl(l) + O_WFFO), DFF, X, xo, ada_l + 5120, mt, nt, smem);
      }
      if (l + 1 < NL) xcd_barrier(xb);
    }
  }
}

extern "C" void kernel_launch(void* const* d_in, const int* in_sizes, int n_in, void* d_out, int out_size,
                              void* d_ws, size_t ws_size, hipStream_t stream) {
  static int grid_blocks = 0;
  if (!grid_blocks) {
    int dev = 0, cus = 0, per_cu = 0;
    (void)hipGetDevice(&dev);
    (void)hipDeviceGetAttribute(&cus, hipDeviceAttributeMultiprocessorCount, dev);
    (void)hipOccupancyMaxActiveBlocksPerMultiprocessor(&per_cu, fwd_megakernel, 256, 0);
    if (per_cu > 2) per_cu = 2;
    if (per_cu < 1) per_cu = 1;
    grid_blocks = cus * per_cu;
    if (ws_size < WS_TOTAL) fprintf(stderr, "kernel_launch: workspace too small: %zu < %zu\n", ws_size, (size_t)WS_TOTAL);
  }
  Params p{};
  for (int i = 0; i < 22; ++i) p.in[i] = (const float*)d_in[i];
  p.out = (float*)d_out;
  p.ws = (char*)d_ws;
  (void)hipMemsetAsync((char*)d_ws + O_BAR, 0, 16384, stream);
  void* args[] = {&p};
  hipError_t e = hipLaunchCooperativeKernel((void*)fwd_megakernel, dim3(grid_blocks), dim3(256), args, 0, stream);
  if (e != hipSuccess) fprintf(stderr, "cooperative launch failed: %s (grid %d)\n", hipGetErrorString(e), grid_blocks);
}
```

```cpp
#include <hip/hip_runtime.h>
#include <hip/hip_cooperative_groups.h>
#include <cstdio>
#include <cstdint>
namespace cg = cooperative_groups;

typedef unsigned short bf16_t;
typedef short bf16x8 __attribute__((ext_vector_type(8)));
typedef float f32x16 __attribute__((ext_vector_type(16)));
typedef float f32x2 __attribute__((ext_vector_type(2)));
typedef __bf16 bf2_t __attribute__((ext_vector_type(2)));
typedef unsigned u32x4 __attribute__((ext_vector_type(4)));
#define DI __device__ __forceinline__
#define MFMA32(a, b, c) __builtin_amdgcn_mfma_f32_32x32x16_bf16((a), (b), (c), 0, 0, 0)

constexpr int NB = 2, S = 8192, D = 1024, NL = 4, T = NB * S;
constexpr int NIN = 4888, NPIN = 4992, DFF = 2816, NFFI = 5632;
constexpr float L2E = 1.4426950408889634f;
constexpr float NEGF = -1e30f;

constexpr size_t O_WIN = 0;
constexpr size_t O_WUPA = O_WIN + (size_t)NPIN * 1024 * 2;
constexpr size_t O_WUPB = O_WUPA + (size_t)1024 * 512 * 2;
constexpr size_t O_WOUT = O_WUPB + (size_t)1024 * 512 * 2;
constexpr size_t O_WFFI = O_WOUT + (size_t)1024 * 1024 * 2;
constexpr size_t O_WFFO = O_WFFI + (size_t)NFFI * 1024 * 2;
constexpr size_t O_CKW1 = O_WFFO + (size_t)1024 * DFF * 2;
constexpr size_t O_CVW1 = O_CKW1 + (size_t)128 * 2048 * 2;
constexpr size_t O_CKW2 = O_CVW1 + (size_t)128 * 2048 * 2;
constexpr size_t O_CVW2 = O_CKW2 + (size_t)64 * 128 * 2;
constexpr size_t O_ADA = O_CVW2 + (size_t)64 * 128 * 2;
constexpr size_t O_COS = O_ADA + (size_t)NL * NB * 6144 * 4;
constexpr size_t O_SIN = O_COS + (size_t)T * 32 * 4;
constexpr size_t O_X = O_SIN + (size_t)T * 32 * 4;
constexpr size_t O_H = O_X + (size_t)T * 1024 * 4;
constexpr size_t O_QA = O_H + (size_t)T * 1024 * 2;
constexpr size_t O_KC = O_QA + (size_t)T * 512 * 2;
constexpr size_t O_VC = O_KC + (size_t)T * 128 * 2;
constexpr size_t O_KS = O_VC + (size_t)T * 128 * 2;
constexpr size_t O_KW = O_KS + (size_t)T * 128 * 2;
constexpr size_t O_VST = O_KW + (size_t)T * 128 * 2;
constexpr size_t O_VWT = O_VST + (size_t)T * 128 * 2;
constexpr size_t O_QB = O_VWT + (size_t)T * 128 * 2;
constexpr size_t O_KB = O_QB + (size_t)T * 512 * 2;
constexpr size_t O_VBT = O_KB + (size_t)T * 512 * 2;
constexpr size_t O_GBR = O_VBT + (size_t)T * 512 * 2;
constexpr size_t O_GA = O_GBR + (size_t)T * 2048 * 2;
constexpr size_t O_KCMP = O_GA + (size_t)T * 24 * 4;
constexpr size_t O_VCMPT = O_KCMP + (size_t)NB * 2 * 512 * 64 * 2;
constexpr size_t O_KMEAN = O_VCMPT + (size_t)NB * 2 * 512 * 64 * 2;
constexpr size_t O_YA = O_KMEAN + (size_t)NB * 8 * 32 * 64 * 2;
constexpr size_t O_YB = O_YA + (size_t)T * 512 * 2;
constexpr size_t WS_END = O_YB + (size_t)T * 512 * 2;
constexpr size_t O_BAR = WS_END;
constexpr size_t O_W2 = O_BAR + 16384;
constexpr size_t WSZ = O_ADA - O_WIN;
constexpr size_t WS_TOTAL = O_W2 + WSZ;
__host__ __device__ constexpr size_t wdl(int l) { return (l & 1) ? (O_W2 - O_WIN) : 0; }
constexpr size_t O_ACT = O_QA;
static_assert((size_t)T * DFF * 2 <= O_GA - O_QA, "ACT alias");

struct Params {
  const float* in[22];
  float* out;
  char* ws;
};

constexpr int SMEM_BYTES = 73728;

DI float xhalf_max(float v) { auto r = __builtin_amdgcn_permlane32_swap(__float_as_uint(v), __float_as_uint(v), false, false); return fmaxf(__uint_as_float(r[0]), __uint_as_float(r[1])); }
DI float xhalf_sum(float v) { auto r = __builtin_amdgcn_permlane32_swap(__float_as_uint(v), __float_as_uint(v), false, false); return __uint_as_float(r[0]) + __uint_as_float(r[1]); }
template <int CTRL> DI unsigned dpp_u(unsigned v) { return (unsigned)__builtin_amdgcn_update_dpp(0, (int)v, CTRL, 0xf, 0xf, true); }
DI float quad_sum(float v) { v += __uint_as_float(dpp_u<0xB1>(__float_as_uint(v))); v += __uint_as_float(dpp_u<0x4E>(__float_as_uint(v))); return v; }
DI int oct_sum(int v) { v += (int)dpp_u<0xB1>((unsigned)v); v += (int)dpp_u<0x4E>((unsigned)v); v += (int)dpp_u<0x141>((unsigned)v); return v; }
DI unsigned oct_or(unsigned v) { v |= dpp_u<0xB1>(v); v |= dpp_u<0x4E>(v); v |= dpp_u<0x141>(v); return v; }
DI int otid() { int t = threadIdx.x; asm volatile("" : "+v"(t)); return t; }
DI unsigned pk2(float a, float b) { f32x2 v = {a, b}; bf2_t r = __builtin_convertvector(v, bf2_t); return __builtin_bit_cast(unsigned, r); }
DI float bf_lo(unsigned u) { return __uint_as_float(u << 16); }
DI float bf_hi(unsigned u) { return __uint_as_float(u & 0xffff0000u); }
DI float bf2f(bf16_t h) { return __uint_as_float(((unsigned)h) << 16); }
DI int crow(int i, int h) { return (i & 3) + 8 * (i >> 2) + 4 * h; }
DI float sigmoidf_(float x) { return __builtin_amdgcn_rcpf(1.f + __expf(-x)); }
DI uint4 pack8(const float* v) { uint4 r; r.x = pk2(v[0], v[1]); r.y = pk2(v[2], v[3]); r.z = pk2(v[4], v[5]); r.w = pk2(v[6], v[7]); return r; }

DI int map_in(int n) {
  if (n < 1280) return n;
  if (n < 4864) return n + 24;
  if (n < 4888) return n - 4864 + 1280;
  return -1;
}
DI int map_ffi(int n) {
  const int tile = n >> 7, within = n & 127, wn = within >> 6, sub = within & 63, isup = sub >> 5, c = sub & 31;
  return (isup ? DFF : 0) + tile * 64 + wn * 32 + c;
}

template <int KT>
DI void conv_tile(const float* __restrict__ src, int srcN, int K, bf16_t* __restrict__ dst, int mode, int nt, int kg, char* smem) {
  float (*st)[65] = (float (*)[65])smem;
  const int tid = otid(), j = tid & 63, i0 = tid >> 6;
  const int n0 = nt * 64, k0 = kg * 64 * KT;
  int ns = n0 + j;
  if (mode == 1) ns = map_in(ns); else if (mode == 2) ns = map_ffi(ns);
  float v[KT * 16];
#pragma unroll
  for (int ii = 0; ii < KT * 16; ++ii) {
    const int k = i0 + 4 * ii;
    v[ii] = ns >= 0 ? src[(size_t)(k0 + k) * srcN + ns] : 0.f;
  }
#pragma unroll
  for (int ii = 0; ii < KT * 16; ++ii) st[i0 + 4 * ii][j] = v[ii];
  __syncthreads();
  const int nrow = tid >> 2, kc = (tid & 3) * 16;
#pragma unroll
  for (int sub = 0; sub < KT; ++sub) {
    float o[16];
#pragma unroll
    for (int q = 0; q < 16; ++q) o[q] = st[sub * 64 + kc + q][nrow];
    uint4* dp = (uint4*)(dst + (size_t)(n0 + nrow) * K + k0 + sub * 64 + kc);
    dp[0] = pack8(o);
    dp[1] = pack8(o + 8);
  }
  __syncthreads();
}

constexpr int CONV_TASKS = 78 * 4 + 32 + 32 + 64 + 88 * 4 + 16 * 11 + 16 + 16 + 1 + 1;

DI void conv_task(const Params& p, int l, int task, char* smem) {
  char* ws = p.ws + wdl(l);
  int t = task;
  if (t < 78 * 4) { conv_tile<4>(p.in[7] + (size_t)l * 1024 * NIN, NIN, 1024, (bf16_t*)(ws + O_WIN), 1, t % 78, t / 78, smem); return; }
  t -= 78 * 4;
  if (t < 32) { conv_tile<4>(p.in[17] + (size_t)l * 512 * 1024, 1024, 512, (bf16_t*)(ws + O_WUPA), 0, t % 16, t / 16, smem); return; }
  t -= 32;
  if (t < 32) { conv_tile<4>(p.in[18] + (size_t)l * 512 * 1024, 1024, 512, (bf16_t*)(ws + O_WUPB), 0, t % 16, t / 16, smem); return; }
  t -= 32;
  if (t < 64) { conv_tile<4>(p.in[19] + (size_t)l * 1024 * 1024, 1024, 1024, (bf16_t*)(ws + O_WOUT), 0, t % 16, t / 16, smem); return; }
  t -= 64;
  if (t < 88 * 4) { conv_tile<4>(p.in[20] + (size_t)l * 1024 * NFFI, NFFI, 1024, (bf16_t*)(ws + O_WFFI), 2, t % 88, t / 88, smem); return; }
  t -= 88 * 4;
  if (t < 16 * 11) { conv_tile<4>(p.in[21] + (size_t)l * DFF * 1024, 1024, DFF, (bf16_t*)(ws + O_WFFO), 0, t % 16, t / 16, smem); return; }
  t -= 16 * 11;
  if (t < 16) { conv_tile<4>(p.in[11] + (size_t)l * 2048 * 128, 128, 2048, (bf16_t*)(ws + O_CKW1), 0, t % 2, t / 2, smem); return; }
  t -= 16;
  if (t < 16) { conv_tile<4>(p.in[13] + (size_t)l * 2048 * 128, 128, 2048, (bf16_t*)(ws + O_CVW1), 0, t % 2, t / 2, smem); return; }
  t -= 16;
  if (t < 1) { conv_tile<2>(p.in[12] + (size_t)l * 128 * 64, 64, 128, (bf16_t*)(ws + O_CKW2), 0, 0, 0, smem); return; }
  conv_tile<2>(p.in[14] + (size_t)l * 128 * 64, 64, 128, (bf16_t*)(ws + O_CVW2), 0, 0, 0, smem);
}

DI void ada_task(const Params& p, int task, char* smem) {
  float* sc = (float*)smem;
  float* red = sc + 2048;
  const int tid = otid(), l = task / 96, n0 = (task % 96) * 64;
  for (int i = tid; i < 2048; i += 256) { const float c = p.in[1][i]; sc[i] = c / (1.f + __expf(-c)); }
  __syncthreads();
  const int j = tid & 63, kq = tid >> 6;
  const float* w = p.in[3] + ((size_t)l * 1024 + kq * 256) * 6144 + n0 + j;
  float a0 = 0.f, a1 = 0.f;
#pragma unroll 8
  for (int k = 0; k < 256; ++k) { const float wv = w[(size_t)k * 6144]; a0 += sc[kq * 256 + k] * wv; a1 += sc[1024 + kq * 256 + k] * wv; }
  red[(kq * 2 + 0) * 64 + j] = a0; red[(kq * 2 + 1) * 64 + j] = a1;
  __syncthreads();
  if (tid < 128) {
    const int b = tid >> 6;
    float s = red[(0 * 2 + b) * 64 + j] + red[(1 * 2 + b) * 64 + j] + red[(2 * 2 + b) * 64 + j] + red[(3 * 2 + b) * 64 + j];
    ((float*)(p.ws + O_ADA))[((size_t)l * 2 + b) * 6144 + n0 + j] = s + p.in[4][(size_t)l * 6144 + n0 + j];
  }
  __syncthreads();
}

DI void rope_task(const Params& p, int task) {
  const int tid = otid(), row = task * 8 + (tid >> 5), i = tid & 31;
  const int pos = ((const int*)p.in[2])[row];
  const float inv = 1.0f / powf(10000.0f, (float)(2 * i) / 64.0f);
  const float ang = (float)pos * inv;
  ((float*)(p.ws + O_COS))[(size_t)row * 32 + i] = cosf(ang);
  ((float*)(p.ws + O_SIN))[(size_t)row * 32 + i] = sinf(ang);
}

DI void norm_rows(const float* __restrict__ xin, const float* __restrict__ gn, const float* __restrict__ ada_sh, const float* __restrict__ ada_sc,
                  bf16_t* __restrict__ H) {
  const int tid_ = otid(), lane = tid_ & 63, w = tid_ >> 6;
  const int nw = gridDim.x * 4;
  for (int row0 = (blockIdx.x * 4 + w) * 8; row0 < T; row0 += nw * 8) {
    const int b = row0 / S;
    float4 v[8][4];
#pragma unroll
    for (int r = 0; r < 8; ++r)
#pragma unroll
      for (int i = 0; i < 4; ++i) v[r][i] = *(const float4*)(xin + (size_t)(row0 + r) * 1024 + (lane + 64 * i) * 4);
    float4 gk[4], sh[4];
#pragma unroll
    for (int i = 0; i < 4; ++i) {
      const int col = (lane + 64 * i) * 4;
      const float4 g = *(const float4*)(gn + col);
      const float4 sc = *(const float4*)(ada_sc + (size_t)b * 6144 + col);
      sh[i] = *(const float4*)(ada_sh + (size_t)b * 6144 + col);
      gk[i].x = g.x * (1.f + sc.x); gk[i].y = g.y * (1.f + sc.y); gk[i].z = g.z * (1.f + sc.z); gk[i].w = g.w * (1.f + sc.w);
    }
    float ss[8];
#pragma unroll
    for (int r = 0; r < 8; ++r) {
      ss[r] = 0.f;
#pragma unroll
      for (int i = 0; i < 4; ++i) ss[r] += v[r][i].x * v[r][i].x + v[r][i].y * v[r][i].y + v[r][i].z * v[r][i].z + v[r][i].w * v[r][i].w;
    }
#pragma unroll
    for (int o = 32; o >= 1; o >>= 1) {
#pragma unroll
      for (int r = 0; r < 8; ++r) ss[r] += __shfl_xor(ss[r], o);
    }
#pragma unroll
    for (int r = 0; r < 8; ++r) {
      const float rr = rsqrtf(ss[r] * (1.f / 1024.f) + 1e-6f);
#pragma unroll
      for (int i = 0; i < 4; ++i) {
        const int col = (lane + 64 * i) * 4;
        uint2 o;
        o.x = pk2(v[r][i].x * rr * gk[i].x + sh[i].x, v[r][i].y * rr * gk[i].y + sh[i].y);
        o.y = pk2(v[r][i].z * rr * gk[i].z + sh[i].z, v[r][i].w * rr * gk[i].w + sh[i].w);
        *(uint2*)(H + (size_t)(row0 + r) * 1024 + col) = o;
      }
    }
  }
}

DI void qk_epilogue(const float* st  , int m0, const float* __restrict__ gain, float scale, bf16_t* __restrict__ dst, int dstride, int dcol0,
                    const float* __restrict__ COS, const float* __restrict__ SIN) {
  const int tid = otid(), row = tid & 127, hd = tid >> 7;
  const float* sp = st + row * 132 + hd * 64;
  float ss = 0.f;
#pragma unroll 4
  for (int j = 0; j < 64; j += 4) { const float4 v = *(const float4*)(sp + j); ss += v.x * v.x + v.y * v.y + v.z * v.z + v.w * v.w; }
  const float rr = rsqrtf(ss * (1.f / 64.f) + 1e-6f);
  const size_t tok = (size_t)(m0 + row);
  bf16_t* dp = dst + tok * dstride + dcol0 + hd * 64;
#pragma unroll 2
  for (int j = 0; j < 32; j += 8) {
    float o1[8], o2[8];
#pragma unroll
    for (int q = 0; q < 8; ++q) {
      const float x1 = sp[j + q] * rr * gain[j + q], x2 = sp[j + q + 32] * rr * gain[j + q + 32];
      const float cs = COS[tok * 32 + j + q], sn = SIN[tok * 32 + j + q];
      o1[q] = (x1 * cs - x2 * sn) * scale;
      o2[q] = (x2 * cs + x1 * sn) * scale;
    }
    *(uint4*)(dp + j) = pack8(o1);
    *(uint4*)(dp + j + 32) = pack8(o2);
  }
}
DI void raw_epilogue(const float* st, int m0, bf16_t* __restrict__ dst, int dstride, int dcol0, bool sig) {
  const int tid = otid(), row = tid & 127, hd = tid >> 7;
  const float* sp = st + row * 132 + hd * 64;
  bf16_t* dp = dst + (size_t)(m0 + row) * dstride + dcol0 + hd * 64;
#pragma unroll 2
  for (int j = 0; j < 64; j += 8) {
    float o[8];
#pragma unroll
    for (int q = 0; q < 8; ++q) { const float v = sp[j + q]; o[q] = sig ? sigmoidf_(v) : v; }
    *(uint4*)(dp + j) = pack8(o);
  }
}
DI void vt_epilogue(const float* st, int m0, bf16_t* __restrict__ dst, int nheads, int head0) {
  const int tid = otid(), col = tid & 127, rh = tid >> 7;
  const int b = m0 / S, s0 = m0 % S, hd = head0 + (col >> 6), d = col & 63;
  bf16_t* dp = dst + ((size_t)(b * nheads + hd) * 64 + d) * S + s0 + rh * 64;
#pragma unroll 2
  for (int r8 = 0; r8 < 8; ++r8) {
    float o[8];
#pragma unroll
    for (int q = 0; q < 8; ++q) o[q] = st[(rh * 64 + r8 * 8 + q) * 132 + col];
    *(uint4*)(dp + r8 * 8) = pack8(o);
  }
}


DI void gemm_mainloop_big(const bf16_t* __restrict__ A, int lda, const bf16_t* __restrict__ Bt, int ldb, int K, int m0, int n0,
                          f32x16 (&acc)[4][2], char* smem) {
  bf16_t (*sa)[72] = (bf16_t (*)[72])smem;
  bf16_t (*sb)[72] = (bf16_t (*)[72])(smem + 256 * 72 * 2);
  const int tid = otid(), lane = tid & 63, w = tid >> 6, wm = w >> 1, wn = w & 1;
  const int r = lane & 31, half = lane >> 5;
  const int nk = K >> 6;
  u32x4 ra[8], rb[4];
  const bf16_t* ap = A + (size_t)(m0 + (tid >> 3)) * lda + (tid & 7) * 8;
  const bf16_t* bp = Bt + (size_t)(n0 + (tid >> 3)) * ldb + (tid & 7) * 8;
#pragma unroll
  for (int i = 0; i < 8; ++i) ra[i] = *(const u32x4*)(ap + (size_t)(32 * i) * lda);
#pragma unroll
  for (int i = 0; i < 4; ++i) rb[i] = *(const u32x4*)(bp + (size_t)(32 * i) * ldb);
  __syncthreads();
#pragma unroll
  for (int i = 0; i < 8; ++i) *(u32x4*)&sa[(tid >> 3) + 32 * i][(tid & 7) * 8] = ra[i];
#pragma unroll
  for (int i = 0; i < 4; ++i) *(u32x4*)&sb[(tid >> 3) + 32 * i][(tid & 7) * 8] = rb[i];
  __syncthreads();
  for (int kt = 0; kt < nk; ++kt) {
    if (kt + 1 < nk) {
#pragma unroll
      for (int i = 0; i < 8; ++i) ra[i] = *(const u32x4*)(ap + (size_t)(32 * i) * lda + (kt + 1) * 64);
#pragma unroll
      for (int i = 0; i < 4; ++i) rb[i] = *(const u32x4*)(bp + (size_t)(32 * i) * ldb + (kt + 1) * 64);
    }
#pragma unroll
    for (int ks = 0; ks < 4; ++ks) {
      bf16x8 af[4], bfr[2];
#pragma unroll
      for (int f = 0; f < 4; ++f) af[f] = *(const bf16x8*)&sa[wm * 128 + f * 32 + r][ks * 16 + half * 8];
#pragma unroll
      for (int f = 0; f < 2; ++f) bfr[f] = *(const bf16x8*)&sb[wn * 64 + f * 32 + r][ks * 16 + half * 8];
#pragma unroll
      for (int mf = 0; mf < 4; ++mf)
#pragma unroll
        for (int nf = 0; nf < 2; ++nf) acc[mf][nf] = MFMA32(af[mf], bfr[nf], acc[mf][nf]);
    }
    __syncthreads();
    if (kt + 1 < nk) {
#pragma unroll
      for (int i = 0; i < 8; ++i) *(u32x4*)&sa[(tid >> 3) + 32 * i][(tid & 7) * 8] = ra[i];
#pragma unroll
      for (int i = 0; i < 4; ++i) *(u32x4*)&sb[(tid >> 3) + 32 * i][(tid & 7) * 8] = rb[i];
    }
    __syncthreads();
  }
}
DI void zero_acc_big(f32x16 (&acc)[4][2]) {
#pragma unroll
  for (int a = 0; a < 4; ++a)
#pragma unroll
    for (int b = 0; b < 2; ++b)
#pragma unroll
      for (int i = 0; i < 16; ++i) acc[a][b][i] = 0.f;
}
DI void stage_half(float* st, const f32x16 (&acc)[4][2], int h, int tid) {
  const int lane = tid & 63, w = tid >> 6, wm = w >> 1, wn = w & 1, c = lane & 31, half = lane >> 5;
  if (wm == h) {
#pragma unroll
    for (int mf = 0; mf < 4; ++mf)
#pragma unroll
      for (int nf = 0; nf < 2; ++nf)
#pragma unroll
        for (int i = 0; i < 16; ++i) st[(mf * 32 + crow(i, half)) * 132 + wn * 64 + nf * 32 + c] = acc[mf][nf][i];
  }
}
DI bool gemm_coords_big(int idx, int NT, int& mt, int& nt) {
  const int x = idx & 7, q = idx >> 3, om = q >> 6, qq = q & 63;
  const int macro = om * 8 + x, Mb = macro & 7, Nb = macro >> 3;
  mt = Mb * 8 + (qq & 7); nt = Nb * 8 + (qq >> 3);
  return nt < NT;
}
DI int gemm_slots_big(int NT) { return 8 * ((NT + 7) / 8) * 64; }

DI void in_epilogue_half(const Params& p, int l, const float* st, int m0, int nt) {
  char* ws = p.ws;
  const float* COS = (const float*)(ws + O_COS);
  const float* SIN = (const float*)(ws + O_SIN);
  if (nt < 4) qk_epilogue(st, m0, p.in[8] + l * 64, 0.125f, (bf16_t*)(ws + O_QA), 512, nt * 128, COS, SIN);
  else if (nt == 4) raw_epilogue(st, m0, (bf16_t*)(ws + O_KC), 128, 0, false);
  else if (nt == 5) raw_epilogue(st, m0, (bf16_t*)(ws + O_VC), 128, 0, false);
  else if (nt == 6) qk_epilogue(st, m0, p.in[9] + l * 64, 1.f, (bf16_t*)(ws + O_KS), 128, 0, COS, SIN);
  else if (nt == 7) vt_epilogue(st, m0, (bf16_t*)(ws + O_VST), 2, 0);
  else if (nt == 8) qk_epilogue(st, m0, p.in[9] + l * 64, 1.f, (bf16_t*)(ws + O_KW), 128, 0, COS, SIN);
  else if (nt == 9) vt_epilogue(st, m0, (bf16_t*)(ws + O_VWT), 2, 0);
  else if (nt < 14) qk_epilogue(st, m0, p.in[15] + l * 64, 0.125f, (bf16_t*)(ws + O_QB), 512, (nt - 10) * 128, COS, SIN);
  else if (nt < 18) qk_epilogue(st, m0, p.in[16] + l * 64, 1.f, (bf16_t*)(ws + O_KB), 512, (nt - 14) * 128, COS, SIN);
  else if (nt < 22) vt_epilogue(st, m0, (bf16_t*)(ws + O_VBT), 8, (nt - 18) * 2);
  else if (nt < 38) raw_epilogue(st, m0, (bf16_t*)(ws + O_GBR), 2048, (nt - 22) * 128, true);
  else {
    const int tid = otid();
    if (tid < 128) {
      float* gp = (float*)(ws + O_GA) + (size_t)(m0 + tid) * 24;
#pragma unroll
      for (int j = 0; j < 24; ++j) gp[j] = sigmoidf_(st[tid * 132 + j]);
    }
  }
}
DI void gemm_in_tile_big(const Params& p, int l, int mt, int nt, char* smem) {
  char* ws = p.ws;
  f32x16 acc[4][2];
  zero_acc_big(acc);
  const int m0 = mt * 256, n0 = nt * 128;
  gemm_mainloop_big((const bf16_t*)(ws + O_H), 1024, (const bf16_t*)(ws + wdl(l) + O_WIN), 1024, 1024, m0, n0, acc, smem);
  float* st = (float*)smem;
#pragma unroll
  for (int h = 0; h < 2; ++h) {
    stage_half(st, acc, h, otid());
    __syncthreads();
    in_epilogue_half(p, l, st, m0 + h * 128, nt);
    __syncthreads();
  }
}
DI void gemm_res_tile_big(const bf16_t* A, int lda, const bf16_t* Bt, int K, const float* __restrict__ xin, float* __restrict__ xout,
                          const float* __restrict__ gate, int mt, int nt, char* smem) {
  const int m0 = mt * 256, n0 = nt * 128;
  f32x16 acc[4][2];
  zero_acc_big(acc);
  gemm_mainloop_big(A, lda, Bt, K, K, m0, n0, acc, smem);
  float* st = (float*)smem;
  const int b = m0 / S;
#pragma unroll
  for (int h = 0; h < 2; ++h) {
    const int tid = otid();
    stage_half(st, acc, h, tid);
    __syncthreads();
    const int r = tid >> 5, ch = tid & 31;
    const float4 g = *(const float4*)(gate + (size_t)b * 6144 + n0 + ch * 4);
#pragma unroll 4
    for (int ps = 0; ps < 16; ++ps) {
      const int row = ps * 8 + r;
      const float4 a = *(const float4*)(st + row * 132 + ch * 4);
      const size_t off = (size_t)(m0 + h * 128 + row) * 1024 + n0 + ch * 4;
      const float4 xi = *(const float4*)(xin + off);
      float4 o; o.x = xi.x + g.x * a.x; o.y = xi.y + g.y * a.y; o.z = xi.z + g.z * a.z; o.w = xi.w + g.w * a.w;
      *(float4*)(xout + off) = o;
    }
    __syncthreads();
  }
}
DI void gemm_ffi_tile_big(const Params& p, int l, int mt, int nt, char* smem) {
  char* ws = p.ws;
  const int m0 = mt * 256, n0 = nt * 128;
  f32x16 acc[4][2];
  zero_acc_big(acc);
  gemm_mainloop_big((const bf16_t*)(ws + O_H), 1024, (const bf16_t*)(ws + wdl(l) + O_WFFI), 1024, 1024, m0, n0, acc, smem);
  bf16_t* ACT = (bf16_t*)(ws + O_ACT);
  bf16_t (*sbt)[72] = (bf16_t (*)[72])smem;
  const int tid = otid(), lane = tid & 63, w = tid >> 6, wm = w >> 1, wn = w & 1, c = lane & 31, half = lane >> 5;
#pragma unroll
  for (int mf = 0; mf < 4; ++mf)
#pragma unroll
    for (int i = 0; i < 16; ++i) {
      const float g = acc[mf][0][i], u = acc[mf][1][i];
      const float a = g * __builtin_amdgcn_rcpf(1.f + __expf(-g)) * u;
      sbt[wm * 128 + mf * 32 + crow(i, half)][wn * 32 + c] = (bf16_t)(pk2(a, 0.f) & 0xffff);
    }
  __syncthreads();
  const int r = tid >> 3, ch = tid & 7;
#pragma unroll
  for (int ps = 0; ps < 8; ++ps) {
    const int row = ps * 32 + r;
    *(u32x4*)(ACT + (size_t)(m0 + row) * DFF + nt * 64 + ch * 8) = *(const u32x4*)&sbt[row][ch * 8];
  }
  __syncthreads();
}
DI void gemm_up_pass_big(const bf16_t* Y, const bf16_t* W, const bf16_t* __restrict__ GBR, int gcol0, bf16_t* __restrict__ MG, bool first,
                         int mt, int nt, char* smem) {
  const int m0 = mt * 256, n0 = nt * 128;
  f32x16 acc[4][2];
  zero_acc_big(acc);
  gemm_mainloop_big(Y, 512, W, 512, 512, m0, n0, acc, smem);
  float* st = (float*)smem;
#pragma unroll
  for (int h = 0; h < 2; ++h) {
    const int tid = otid();
    stage_half(st, acc, h, tid);
    __syncthreads();
    const int r = tid >> 4, ch = tid & 15;
#pragma unroll 2
    for (int ps = 0; ps < 8; ++ps) {
      const int row = ps * 16 + r;
      const float4 a0 = *(const float4*)(st + row * 132 + ch * 8), a1 = *(const float4*)(st + row * 132 + ch * 8 + 4);
      const size_t grow = (size_t)(m0 + h * 128 + row);
      const u32x4 gv = *(const u32x4*)(GBR + grow * 2048 + gcol0 + n0 + ch * 8);
      float v[8];
      v[0] = bf_lo(gv.x) * a0.x; v[1] = bf_hi(gv.x) * a0.y; v[2] = bf_lo(gv.y) * a0.z; v[3] = bf_hi(gv.y) * a0.w;
      v[4] = bf_lo(gv.z) * a1.x; v[5] = bf_hi(gv.z) * a1.y; v[6] = bf_lo(gv.w) * a1.z; v[7] = bf_hi(gv.w) * a1.w;
      bf16_t* mp = MG + grow * 1024 + n0 + ch * 8;
      if (!first) {
        const u32x4 pv = *(const u32x4*)mp;
        v[0] += bf_lo(pv.x); v[1] += bf_hi(pv.x); v[2] += bf_lo(pv.y); v[3] += bf_hi(pv.y);
        v[4] += bf_lo(pv.z); v[5] += bf_hi(pv.z); v[6] += bf_lo(pv.w); v[7] += bf_hi(pv.w);
      }
      u32x4 ov; ov.x = pk2(v[0], v[1]); ov.y = pk2(v[2], v[3]); ov.z = pk2(v[4], v[5]); ov.w = pk2(v[6], v[7]);
      *(u32x4*)mp = ov;
    }
    __syncthreads();
  }
}

DI float gelu_tanh(float x) {
  const float u = 0.7978845608028654f * (x + 0.044715f * x * x * x);
  const float e = __expf(2.f * u);
  const float th = 1.f - 2.f / (e + 1.f);
  return 0.5f * x * (1.f + th);
}

DI void cmp_tile(const Params& p, int l, int tile, char* smem) {
  char* ws = p.ws;
  const int kv = tile & 1, bg = (tile >> 1) & 3, nb = tile >> 3, b = bg >> 1, g = bg & 1;
  const int tid = otid(), lane = tid & 63, w = tid >> 6, r = lane & 31, half = lane >> 5;
  const bf16_t* src = (const bf16_t*)(ws + (kv ? O_VC : O_KC));
  const bf16_t* W1T = (const bf16_t*)(ws + wdl(l) + (kv ? O_CVW1 : O_CKW1));
  const bf16_t* W2T = (const bf16_t*)(ws + wdl(l) + (kv ? O_CVW2 : O_CKW2));
  const float* pe = p.in[10] + (size_t)l * 32 * 64;
  bf16_t (*hid)[136] = (bf16_t (*)[136])smem;
  float (*outf)[68] = (float (*)[68])(smem + 8704);
  int n = nb * 32 + r; if (n > 510) n = 510;
  const bf16_t* arow = src + ((size_t)b * S + 16 * n) * 128 + g * 64 + half * 8;
  float (*part)[32][128] = (float (*)[32][128])smem;
  f32x16 acc[4];
#pragma unroll
  for (int nf = 0; nf < 4; ++nf)
#pragma unroll
    for (int i = 0; i < 16; ++i) acc[nf][i] = 0.f;
  const bf16_t* brow = W1T + (size_t)r * 2048 + half * 8;
#pragma unroll 2
  for (int t8 = 0; t8 < 8; ++t8) {
    const int tl = 8 * w + t8;
#pragma unroll
    for (int dk = 0; dk < 4; ++dk) {
      const uint4 av = *(const uint4*)(arow + (size_t)tl * 128 + dk * 16);
      const float4 p0 = *(const float4*)(pe + tl * 64 + dk * 16 + half * 8);
      const float4 p1 = *(const float4*)(pe + tl * 64 + dk * 16 + half * 8 + 4);
      uint4 a2;
      a2.x = pk2(bf_lo(av.x) + p0.x, bf_hi(av.x) + p0.y);
      a2.y = pk2(bf_lo(av.y) + p0.z, bf_hi(av.y) + p0.w);
      a2.z = pk2(bf_lo(av.z) + p1.x, bf_hi(av.z) + p1.y);
      a2.w = pk2(bf_lo(av.w) + p1.z, bf_hi(av.w) + p1.w);
      const bf16x8 a8 = __builtin_bit_cast(bf16x8, a2);
#pragma unroll
      for (int nf = 0; nf < 4; ++nf) {
        const bf16x8 bv = *(const bf16x8*)(brow + (size_t)(nf * 32) * 2048 + tl * 64 + dk * 16);
        acc[nf] = MFMA32(a8, bv, acc[nf]);
      }
    }
  }
  __syncthreads();
#pragma unroll
  for (int nf = 0; nf < 4; ++nf)
#pragma unroll
    for (int i = 0; i < 16; ++i) part[w][crow(i, half)][nf * 32 + r] = acc[nf][i];
  __syncthreads();
  float hv[16];
#pragma unroll
  for (int e = 0; e < 16; ++e) {
    const int idx = tid + 256 * e, row = idx >> 7, col = idx & 127;
    hv[e] = gelu_tanh((part[0][row][col] + part[1][row][col]) + (part[2][row][col] + part[3][row][col]));
  }
  __syncthreads();
#pragma unroll
  for (int e = 0; e < 16; ++e) {
    const int idx = tid + 256 * e, row = idx >> 7, col = idx & 127;
    hid[row][col] = (bf16_t)(pk2(hv[e], 0.f) & 0xffff);
  }
  __syncthreads();
  if (w < 2) {
    f32x16 a2;
#pragma unroll
    for (int i = 0; i < 16; ++i) a2[i] = 0.f;
#pragma unroll
    for (int ks = 0; ks < 8; ++ks) {
      const bf16x8 av = *(const bf16x8*)&hid[r][ks * 16 + half * 8];
      const bf16x8 bv = *(const bf16x8*)(W2T + (size_t)(32 * w + r) * 128 + ks * 16 + half * 8);
      a2 = MFMA32(av, bv, a2);
    }
#pragma unroll
    for (int i = 0; i < 16; ++i) outf[crow(i, half)][32 * w + r] = a2[i];
  }
  __syncthreads();
  if (kv == 0) {
    const int row = tid >> 3, part = tid & 7, nn = nb * 32 + row;
    float ss = 0.f;
#pragma unroll
    for (int q = 0; q < 8; ++q) { const float v = outf[row][part * 8 + q]; ss += v * v; }
    ss += __shfl_xor(ss, 1); ss += __shfl_xor(ss, 2); ss += __shfl_xor(ss, 4);
    const float rr = rsqrtf(ss * (1.f / 64.f) + 1e-6f);
    const int j0 = (part & 3) * 8, hi = part >> 2;
    const float* gain = p.in[9] + l * 64;
    const int nc = nn > 510 ? 510 : nn;
    const size_t prow = (size_t)b * S + 16 * nc + 31;
    const float* COS = (const float*)(ws + O_COS) + prow * 32;
    const float* SIN = (const float*)(ws + O_SIN) + prow * 32;
    float o[8];
#pragma unroll
    for (int q = 0; q < 8; ++q) {
      const float x1 = outf[row][j0 + q] * rr * gain[j0 + q], x2 = outf[row][j0 + q + 32] * rr * gain[j0 + q + 32];
      const float cs = COS[j0 + q], sn = SIN[j0 + q];
      const float v = hi ? (x2 * cs + x1 * sn) : (x1 * cs - x2 * sn);
      o[q] = nn > 510 ? 0.f : v;
    }
    *(uint4*)((bf16_t*)(ws + O_KCMP) + ((size_t)(b * 2 + g) * 512 + nn) * 64 + hi * 32 + j0) = pack8(o);
  } else {
    const int d = tid & 63, ng = tid >> 6;
    float o[8];
#pragma unroll
    for (int q = 0; q < 8; ++q) { const int nn = nb * 32 + ng * 8 + q; o[q] = nn > 510 ? 0.f : outf[ng * 8 + q][d]; }
    *(uint4*)((bf16_t*)(ws + O_VCMPT) + ((size_t)(b * 2 + g) * 64 + d) * 512 + nb * 32 + ng * 8) = pack8(o);
  }
  __syncthreads();
}

DI void kmean_task(const Params& p, int task, char* smem) {
  char* ws = p.ws;
  float* red = (float*)smem;
  const int tid = otid(), cq = task & 3, blk = (task >> 2) & 31, b = task >> 7;
  const int cp = tid & 63, tq = tid >> 6;
  const bf16_t* kp = (const bf16_t*)(ws + O_KB) + ((size_t)b * S + blk * 256 + tq * 64) * 512 + cq * 128 + cp * 2;
  float a0 = 0.f, a1 = 0.f;
#pragma unroll 8
  for (int k = 0; k < 64; ++k) { const unsigned u = *(const unsigned*)(kp + (size_t)k * 512); a0 += bf_lo(u); a1 += bf_hi(u); }
  red[tq * 128 + cp * 2] = a0; red[tq * 128 + cp * 2 + 1] = a1;
  __syncthreads();
  if (tid < 128) {
    const float s = (red[tid] + red[128 + tid] + red[256 + tid] + red[384 + tid]) * (1.f / 256.f);
    const int col = cq * 128 + tid, h = col >> 6, d = col & 63;
    ((bf16_t*)(ws + O_KMEAN))[((size_t)(b * 8 + h) * 32 + blk) * 64 + d] = (bf16_t)(pk2(s, 0.f) & 0xffff);
  }
  __syncthreads();
}

struct AttnSmem {
  bf16_t k[2][64][72];
  bf16_t vt[2][64][72];
  float imp[32][136];
  unsigned selmask[32][4];
};
static_assert(sizeof(AttnSmem) <= SMEM_BYTES, "smem");

DI void ld_tile(int tid, const bf16_t* __restrict__ kp, int kstride, const bf16_t* __restrict__ vp, int vstride, u32x4 (&r)[4]) {
#pragma unroll
  for (int i = 0; i < 2; ++i) {
    const int id = tid + 256 * i, row = id >> 3, c = id & 7;
    r[i] = *(const u32x4*)(kp + (size_t)row * kstride + c * 8);
    r[2 + i] = *(const u32x4*)(vp + (size_t)row * vstride + c * 8);
  }
}
DI void st_tile(int tid, AttnSmem& sm, int buf, const u32x4 (&r)[4]) {
#pragma unroll
  for (int i = 0; i < 2; ++i) {
    const int id = tid + 256 * i, row = id >> 3, c = id & 7;
    *(u32x4*)&sm.k[buf][row][c * 8] = r[i];
    *(u32x4*)&sm.vt[buf][row][c * 8] = r[2 + i];
  }
}

template <class Body>
DI void kv_loop(int tid, AttnSmem& sm, const bf16_t* kp, int kstride, const bf16_t* vp, int vstride, int tlo, int thi, Body body) {
  const int n = thi - tlo;
  if (n <= 0) return;
  u32x4 r0[4], r1[4];
  ld_tile(tid, kp + (size_t)tlo * 64 * kstride, kstride, vp + (size_t)tlo * 64, vstride, r0);
  if (n > 1) ld_tile(tid, kp + (size_t)(tlo + 1) * 64 * kstride, kstride, vp + (size_t)(tlo + 1) * 64, vstride, r1);
  __syncthreads();
  st_tile(tid, sm, 0, r0);
  __syncthreads();
  for (int i = 0; i < n; i += 2) {
    if (i + 2 < n) ld_tile(tid, kp + (size_t)(tlo + i + 2) * 64 * kstride, kstride, vp + (size_t)(tlo + i + 2) * 64, vstride, r0);
    body(tlo + i, 0);
    if (i + 1 < n) st_tile(tid, sm, 1, r1);
    __syncthreads();
    if (i + 1 >= n) break;
    if (i + 3 < n) ld_tile(tid, kp + (size_t)(tlo + i + 3) * 64 * kstride, kstride, vp + (size_t)(tlo + i + 3) * 64, vstride, r1);
    body(tlo + i + 1, 1);
    if (i + 2 < n) st_tile(tid, sm, 0, r0);
    __syncthreads();
  }
}

DI void qk_scores(int lane, const bf16_t (*sk)[72], int kk, const bf16x8 (&q)[4], f32x16& s) {
  const int r = lane & 31, half = lane >> 5;
  const int pr = (r & 0x13) | ((r & 4) << 1) | ((r & 8) >> 1);
#pragma unroll
  for (int i = 0; i < 16; ++i) s[i] = 0.f;
#pragma unroll
  for (int ks = 0; ks < 4; ++ks) {
    const bf16x8 a = *(const bf16x8*)&sk[kk * 32 + pr][ks * 16 + half * 8];
    s = MFMA32(a, q[ks], s);
  }
}

DI float max16(const f32x16& s) {
  float m = s[0];
#pragma unroll
  for (int j = 1; j < 16; ++j) m = fmaxf(m, s[j]);
  return m;
}
DI f32x2 mk2(float a, float b) { f32x2 r = {a, b}; return r; }
template <bool ELEM>
DI void attn_step64(int lane, const bf16_t (*sk)[72], const bf16_t (*svt)[72], const bf16x8 (&q)[4], f32x16 (&o)[2], float& m, float& l,
                    bool lane_on, int key0, int lo, int hi) {
  const int r = lane & 31, half = lane >> 5;
  const int pr = (r & 0x13) | ((r & 4) << 1) | ((r & 8) >> 1);
  f32x16 s0, s1;
#pragma unroll
  for (int i = 0; i < 16; ++i) { s0[i] = 0.f; s1[i] = 0.f; }
#pragma unroll
  for (int ks = 0; ks < 4; ++ks) {
    const bf16x8 a0 = *(const bf16x8*)&sk[pr][ks * 16 + half * 8];
    const bf16x8 a1 = *(const bf16x8*)&sk[32 + pr][ks * 16 + half * 8];
    s0 = MFMA32(a0, q[ks], s0);
    s1 = MFMA32(a1, q[ks], s1);
  }
  if (ELEM) {
#pragma unroll
    for (int i = 0; i < 16; ++i) {
      const int key = key0 + (i & 7) + 8 * half + 16 * (i >> 3);
      const bool ok0 = lane_on && key >= lo && key <= hi;
      const bool ok1 = lane_on && (key + 32) >= lo && (key + 32) <= hi;
      s0[i] = ok0 ? s0[i] : NEGF;
      s1[i] = ok1 ? s1[i] : NEGF;
    }
  }
  float mx = fmaxf(max16(s0), max16(s1));
  if (!ELEM && !lane_on) mx = NEGF;
  mx = xhalf_max(mx);
  const bool upd = (mx - m) * L2E > 8.f;
  if (__any(upd)) {
    const float mnew = upd ? mx : m;
    const float alpha = __builtin_amdgcn_exp2f((m - mnew) * L2E);
    l *= alpha;
    m = mnew;
    const f32x2 al2 = mk2(alpha, alpha);
#pragma unroll
    for (int mt = 0; mt < 2; ++mt)
#pragma unroll
      for (int i = 0; i < 16; i += 2) { f32x2 v = mk2(o[mt][i], o[mt][i + 1]); v = v * al2; o[mt][i] = v.x; o[mt][i + 1] = v.y; }
  }
  float mb = (m < -1e29f) ? 0.f : m * L2E;
  if (!ELEM && !lane_on) mb = __builtin_inff();
  const f32x2 l2e2 = mk2(L2E, L2E), nmb2 = mk2(-mb, -mb);
  f32x2 sum0 = mk2(0.f, 0.f), sum1 = mk2(0.f, 0.f);
#pragma unroll
  for (int i = 0; i < 16; i += 2) {
    f32x2 v0 = __builtin_elementwise_fma(mk2(s0[i], s0[i + 1]), l2e2, nmb2);
    f32x2 v1 = __builtin_elementwise_fma(mk2(s1[i], s1[i + 1]), l2e2, nmb2);
    v0.x = __builtin_amdgcn_exp2f(v0.x); v0.y = __builtin_amdgcn_exp2f(v0.y);
    v1.x = __builtin_amdgcn_exp2f(v1.x); v1.y = __builtin_amdgcn_exp2f(v1.y);
    sum0 += v0; sum1 += v1;
    s0[i] = v0.x; s0[i + 1] = v0.y; s1[i] = v1.x; s1[i + 1] = v1.y;
  }
  sum0 += sum1;
  l += sum0.x + sum0.y;
#pragma unroll
  for (int j = 0; j < 4; ++j) {
    uint4 pu;
    if (j < 2) { pu.x = pk2(s0[8 * j], s0[8 * j + 1]); pu.y = pk2(s0[8 * j + 2], s0[8 * j + 3]); pu.z = pk2(s0[8 * j + 4], s0[8 * j + 5]); pu.w = pk2(s0[8 * j + 6], s0[8 * j + 7]); }
    else { const int jj = j - 2; pu.x = pk2(s1[8 * jj], s1[8 * jj + 1]); pu.y = pk2(s1[8 * jj + 2], s1[8 * jj + 3]); pu.z = pk2(s1[8 * jj + 4], s1[8 * jj + 5]); pu.w = pk2(s1[8 * jj + 6], s1[8 * jj + 7]); }
    const bf16x8 pb = __builtin_bit_cast(bf16x8, pu);
#pragma unroll
    for (int mt = 0; mt < 2; ++mt) {
      const bf16x8 a = *(const bf16x8*)&svt[mt * 32 + r][j * 16 + half * 8];
      o[mt] = MFMA32(a, pb, o[mt]);
    }
  }
}

DI void zero_o(f32x16 (&o)[2]) {
#pragma unroll
  for (int a = 0; a < 2; ++a)
#pragma unroll
    for (int i = 0; i < 16; ++i) o[a][i] = 0.f;
}

DI void nsa_tile(const Params& p, int rank, char* smem) {
  char* ws = p.ws;
  AttnSmem& sm = *(AttnSmem*)smem;
  const int bg = rank & 3, b = bg >> 1, g = bg & 1, t0 = (255 - (rank >> 2)) * 32;
  const int tid = otid(), lane = tid & 63, w = tid >> 6, c = lane & 31, half = lane >> 5;
  const int tokl = w * 8 + (c >> 2), hh = c & 3, t = t0 + tokl, head = g * 4 + hh;
  __syncthreads();
  for (int i = tid; i < 32 * 136; i += 256) (&sm.imp[0][0])[i] = 0.f;
  bf16x8 q[4];
  {
    const bf16_t* qp = (const bf16_t*)(ws + O_QA) + ((size_t)b * S + t) * 512 + head * 64 + half * 8;
#pragma unroll
    for (int ks = 0; ks < 4; ++ks) q[ks] = *(const bf16x8*)(qp + ks * 16);
  }
  const float* gap = (const float*)(ws + O_GA) + ((size_t)b * S + t) * 24 + head * 3;
  const float g0 = gap[0], g1 = gap[1], g2 = gap[2];
  f32x16 y[2];
  zero_o(y);

  {
    const int nlim = (t - 31) >> 4;
    const int ntile = ((t0 >> 4) >> 6) + 1;
    const bf16_t* kp = (const bf16_t*)(ws + O_KCMP) + (size_t)(b * 2 + g) * 512 * 64;
    const bf16_t* vp = (const bf16_t*)(ws + O_VCMPT) + (size_t)(b * 2 + g) * 64 * 512;
    f32x16 o[2];
    zero_o(o);
    float m = NEGF, l = 0.f;
    kv_loop(tid, sm, kp, 64, vp, 512, 0, ntile, [&](int it, int buf) {
      attn_step64<true>(lane, sm.k[buf], sm.vt[buf], q, o, m, l, true, it * 64, 0, nlim);
    });
    const float lt = xhalf_sum(l);
    const float inv = lt > 0.f ? 1.f / lt : 0.f;
    const float sc = g0 * inv;
#pragma unroll
    for (int mt = 0; mt < 2; ++mt)
#pragma unroll
      for (int i = 0; i < 16; ++i) y[mt][i] += sc * o[mt][i];
    const float mbl = (m < -1e29f) ? 0.f : m * L2E;
    kv_loop(tid, sm, kp, 64, vp, 512, 0, ntile, [&](int it, int buf) {
#pragma unroll
      for (int kk = 0; kk < 2; ++kk) {
        f32x16 s;
        qk_scores(lane, sm.k[buf], kk, q, s);
        float pn[16];
#pragma unroll
        for (int i = 0; i < 16; ++i) {
          const int n = it * 64 + kk * 32 + (i & 7) + 8 * half + 16 * (i >> 3);
          const float e = __builtin_amdgcn_exp2f(fmaf(s[i], L2E, -mbl)) * inv;
          pn[i] = (n <= nlim) ? e : 0.f;
        }
#pragma unroll
        for (int j = 0; j < 2; ++j) {
          float v0 = (pn[8 * j] + pn[8 * j + 1]) + (pn[8 * j + 2] + pn[8 * j + 3]);
          float v1 = (pn[8 * j + 4] + pn[8 * j + 5]) + (pn[8 * j + 6] + pn[8 * j + 7]) + pn[8 * j + 3];
          float v2 = pn[8 * j + 7];
          v0 = quad_sum(v0); v1 = quad_sum(v1); v2 = quad_sum(v2);
          if (hh == 0) {
            const int Ja = (it * 64 + kk * 32 + 16 * j + 8 * half) >> 2;
            if (Ja < 128) atomicAdd(&sm.imp[tokl][Ja], v0);
            if (Ja + 1 < 128) atomicAdd(&sm.imp[tokl][Ja + 1], v1);
            if (Ja + 2 < 128) atomicAdd(&sm.imp[tokl][Ja + 2], v2);
          }
        }
      }
    });
  }
  __syncthreads();
  {
    const int tk = w * 8 + (lane >> 3), sub = lane & 7, tt = t0 + tk, jown = tt >> 6;
    unsigned key[16];
#pragma unroll
    for (int i = 0; i < 16; ++i) {
      const int J = i * 8 + sub;
      float v = sm.imp[tk][J];
      if (J == 0 || J == jown) v = 1e4f;
      if (J * 64 > tt) v = NEGF;
      const unsigned u = __float_as_uint(v);
      const unsigned ok = (u & 0x80000000u) ? ~u : (u | 0x80000000u);
      key[i] = (ok & ~127u) | (unsigned)(127 - J);
    }
    unsigned Tk = 0;
    for (int bit = 31; bit >= 0; --bit) {
      const unsigned cand = Tk | (1u << bit);
      int cnt = 0;
#pragma unroll
      for (int i = 0; i < 16; ++i) cnt += (key[i] >= cand) ? 1 : 0;
      cnt = oct_sum(cnt);
      if (cnt >= 16) Tk = cand;
    }
    unsigned wb[4] = {0u, 0u, 0u, 0u};
#pragma unroll
    for (int i = 0; i < 16; ++i) if (key[i] >= Tk) wb[i >> 2] |= 1u << (8 * (i & 3) + sub);
#pragma unroll
    for (int k = 0; k < 4; ++k) wb[k] = oct_or(wb[k]);
    if (sub == 0) { sm.selmask[tk][0] = wb[0]; sm.selmask[tk][1] = wb[1]; sm.selmask[tk][2] = wb[2]; sm.selmask[tk][3] = wb[3]; }
  }
  __syncthreads();
  {
    const int jown = t0 >> 6;
    const bf16_t* kp = (const bf16_t*)(ws + O_KS) + (size_t)b * S * 128 + g * 64;
    const bf16_t* vp = (const bf16_t*)(ws + O_VST) + (size_t)(b * 2 + g) * 64 * S;
    f32x16 o[2];
    zero_o(o);
    float m = NEGF, l = 0.f;
    kv_loop(tid, sm, kp, 128, vp, S, 0, jown, [&](int it, int buf) {
      const bool on = (sm.selmask[tokl][it >> 5] >> (it & 31)) & 1u;
      if (__any(on)) attn_step64<false>(lane, sm.k[buf], sm.vt[buf], q, o, m, l, on, it * 64, 0, t);
    });
    kv_loop(tid, sm, kp, 128, vp, S, jown, jown + 1, [&](int it, int buf) {
      const bool on = (sm.selmask[tokl][it >> 5] >> (it & 31)) & 1u;
      attn_step64<true>(lane, sm.k[buf], sm.vt[buf], q, o, m, l, on, it * 64, 0, t);
    });
    const float lt = xhalf_sum(l);
    const float sc = g1 * (lt > 0.f ? 1.f / lt : 0.f);
#pragma unroll
    for (int mt = 0; mt < 2; ++mt)
#pragma unroll
      for (int i = 0; i < 16; ++i) y[mt][i] += sc * o[mt][i];
  }
  {
    const int tl0 = (t0 - 511) < 0 ? 0 : ((t0 - 511) >> 6);
    const bf16_t* kp = (const bf16_t*)(ws + O_KW) + (size_t)b * S * 128 + g * 64;
    const bf16_t* vp = (const bf16_t*)(ws + O_VWT) + (size_t)(b * 2 + g) * 64 * S;
    f32x16 o[2];
    zero_o(o);
    float m = NEGF, l = 0.f;
    kv_loop(tid, sm, kp, 128, vp, S, tl0, (t0 >> 6) + 1, [&](int it, int buf) {
      attn_step64<true>(lane, sm.k[buf], sm.vt[buf], q, o, m, l, true, it * 64, t - 511, t);
    });
    const float lt = xhalf_sum(l);
    const float sc = g2 * (lt > 0.f ? 1.f / lt : 0.f);
#pragma unroll
    for (int mt = 0; mt < 2; ++mt)
#pragma unroll
      for (int i = 0; i < 16; ++i) y[mt][i] += sc * o[mt][i];
  }
  {
    bf16_t* yp = (bf16_t*)(ws + O_YA) + ((size_t)b * S + t) * 512 + head * 64;
#pragma unroll
    for (int mt = 0; mt < 2; ++mt)
#pragma unroll
      for (int g4 = 0; g4 < 4; ++g4) {
        uint2 u; u.x = pk2(y[mt][4 * g4], y[mt][4 * g4 + 1]); u.y = pk2(y[mt][4 * g4 + 2], y[mt][4 * g4 + 3]);
        *(uint2*)(yp + 32 * mt + 8 * g4 + 4 * half) = u;
      }
  }
}

DI void moba_tile(const Params& p, int rank, char* smem) {
  char* ws = p.ws;
  AttnSmem& sm = *(AttnSmem*)smem;
  const int bh = rank & 15, b = bh >> 3, h = bh & 7, s0 = (63 - (rank >> 4)) * 128, own = s0 >> 8;
  const int tid = otid(), lane = tid & 63, w = tid >> 6, c = lane & 31, half = lane >> 5;
  const int t = s0 + w * 32 + c;
  bf16x8 q[4];
  {
    const bf16_t* qp = (const bf16_t*)(ws + O_QB) + ((size_t)b * S + t) * 512 + h * 64 + half * 8;
#pragma unroll
    for (int ks = 0; ks < 4; ++ks) q[ks] = *(const bf16x8*)(qp + ks * 16);
  }
  unsigned selbits = 0;
  if (own > 0) {
    f32x16 s;
#pragma unroll
    for (int i = 0; i < 16; ++i) s[i] = 0.f;
    const bf16_t* km = (const bf16_t*)(ws + O_KMEAN) + ((size_t)(b * 8 + h) * 32 + c) * 64 + half * 8;
#pragma unroll
    for (int ks = 0; ks < 4; ++ks) { const bf16x8 a = *(const bf16x8*)(km + ks * 16); s = MFMA32(a, q[ks], s); }
    unsigned key[16];
#pragma unroll
    for (int i = 0; i < 16; ++i) {
      const int blk = crow(i, half);
      const unsigned u = __float_as_uint(s[i]);
      const unsigned ok = (u & 0x80000000u) ? ~u : (u | 0x80000000u);
      key[i] = blk < own ? ((ok & ~31u) | (unsigned)(31 - blk)) : 0u;
    }
#pragma unroll
    for (int rnd = 0; rnd < 3; ++rnd) {
      unsigned mx = 0;
#pragma unroll
      for (int i = 0; i < 16; ++i) mx = key[i] > mx ? key[i] : mx;
      const unsigned ox = (unsigned)__shfl_xor((int)mx, 32);
      const unsigned win = mx > ox ? mx : ox;
      if (win != 0u) selbits |= 1u << (31 - (win & 31u));
#pragma unroll
      for (int i = 0; i < 16; ++i) key[i] = (key[i] == win) ? 0u : key[i];
    }
  }
  const bf16_t* kp = (const bf16_t*)(ws + O_KB) + (size_t)b * S * 512 + h * 64;
  const bf16_t* vp = (const bf16_t*)(ws + O_VBT) + (size_t)(b * 8 + h) * 64 * S;
  f32x16 o[2];
  zero_o(o);
  float m = NEGF, l = 0.f;
  const int tq_hi = s0 + w * 32 + 31;
  kv_loop(tid, sm, kp, 512, vp, S, 0, own * 4, [&](int it, int buf) {
    const bool on = (selbits >> (it >> 2)) & 1u;
    if (__any(on)) attn_step64<false>(lane, sm.k[buf], sm.vt[buf], q, o, m, l, on, it * 64, 0, t);
  });
  kv_loop(tid, sm, kp, 512, vp, S, own * 4, ((s0 + 127) >> 6) + 1, [&](int it, int buf) {
    if (it * 64 <= tq_hi) attn_step64<true>(lane, sm.k[buf], sm.vt[buf], q, o, m, l, true, it * 64, 0, t);
  });
  const float lt = xhalf_sum(l);
  const float inv = lt > 0.f ? 1.f / lt : 0.f;
  bf16_t* yp = (bf16_t*)(ws + O_YB) + ((size_t)b * S + t) * 512 + h * 64;
#pragma unroll
  for (int mt = 0; mt < 2; ++mt)
#pragma unroll
    for (int g4 = 0; g4 < 4; ++g4) {
      uint2 u; u.x = pk2(o[mt][4 * g4] * inv, o[mt][4 * g4 + 1] * inv); u.y = pk2(o[mt][4 * g4 + 2] * inv, o[mt][4 * g4 + 3] * inv);
      *(uint2*)(yp + 32 * mt + 8 * g4 + 4 * half) = u;
    }
}


#define XB_TMO      128
#define XB_XCNT(j)  (256  + 64 * (j))
#define XB_XSUB(j)  (1280 + 64 * (j))
#define XB_XGEN(j)  (2304 + 64 * (j))
#define XB_TOP      3328
#define XB_TOPGEN   3392
#define XCD_BAR_WORDS 3456
#define XB_SPIN_CAP (1u << 20)
#define LAS __attribute__((address_space(3)))
DI unsigned xb_ld(unsigned* p)              { return __hip_atomic_load(p, __ATOMIC_RELAXED, __HIP_MEMORY_SCOPE_AGENT); }
DI unsigned xb_add(unsigned* p, unsigned v) { return __hip_atomic_fetch_add(p, v, __ATOMIC_RELAXED, __HIP_MEMORY_SCOPE_AGENT); }
DI unsigned xb_xcc_id() { return (unsigned)__builtin_amdgcn_s_getreg((3 << 11) | 20) & 0xFu; }
#define XB_SPIN(cond, bar) do { unsigned _sp = 0; while (cond) { __builtin_amdgcn_s_sleep(1); \
    if ((++_sp & 255u) == 0u) { if (xb_ld(&(bar)[XB_TMO])) break; if (_sp > XB_SPIN_CAP) { atomicAdd(&(bar)[XB_TMO], 1u); break; } } } } while (0)
struct XcdBarrier { unsigned* bar; unsigned x; volatile LAS unsigned* st; };
DI XcdBarrier xcd_barrier_post(unsigned* bar, volatile LAS unsigned* st) {
  XcdBarrier b; b.bar = bar; b.x = xb_xcc_id(); b.st = st;
  if (threadIdx.x == 0) (void)xb_add(&bar[XB_XCNT(b.x)], 1u);
  return b;
}
DI void xcd_barrier_complete(unsigned* bar, unsigned x, unsigned& nloc, unsigned& nx) {
  const unsigned G = gridDim.x * gridDim.y * gridDim.z;
  unsigned sum, cnt, mine, sp = 0u;
  for (;;) {
    sum = 0u; cnt = 0u; mine = 0u;
#pragma unroll
    for (unsigned j = 0; j < 16; ++j) { const unsigned c = xb_ld(&bar[XB_XCNT(j)]); sum += c; cnt += (c > 0u) ? 1u : 0u; mine = (j == x) ? c : mine; }
    if (sum == G) break;
    __builtin_amdgcn_s_sleep(1);
    if ((++sp & 255u) == 0u) { if (xb_ld(&bar[XB_TMO])) break; if (sp > XB_SPIN_CAP) { atomicAdd(&bar[XB_TMO], 1u); break; } }
  }
  nloc = mine > 0u ? mine : 1u; nx = cnt > 0u ? cnt : 1u;
}
DI void xcd_barrier(const XcdBarrier& b) {
  asm volatile("s_waitcnt vmcnt(0)" ::: "memory");
  __syncthreads();
  if (threadIdx.x == 0) {
    unsigned* bar = b.bar;
    __builtin_amdgcn_s_waitcnt(0);
    unsigned nloc = b.st[0], nx = b.st[1];
    if (nloc == 0u) { xcd_barrier_complete(bar, b.x, nloc, nx); b.st[0] = nloc; b.st[1] = nx; }
    const unsigned old = xb_add(&bar[XB_XSUB(b.x)], 1u);
    const unsigned gen = old / nloc;
    if (old + 1u == (gen + 1u) * nloc) {
      __builtin_amdgcn_fence(__ATOMIC_RELEASE, "agent");
      asm volatile("s_waitcnt vmcnt(0)" ::: "memory");
      const unsigned og = xb_add(&bar[XB_TOP], 1u);
      const unsigned tg = og / nx;
      if (og + 1u == (tg + 1u) * nx) xb_add(&bar[XB_TOPGEN], 1u);
      else XB_SPIN(xb_ld(&bar[XB_TOPGEN]) == tg, bar);
      __builtin_amdgcn_fence(__ATOMIC_ACQUIRE, "agent");
      xb_add(&bar[XB_XGEN(b.x)], 1u);
      asm volatile("s_waitcnt vmcnt(0)" ::: "memory");
    } else {
      XB_SPIN(xb_ld(&bar[XB_XGEN(b.x)]) == gen, bar);
      __builtin_amdgcn_fence(__ATOMIC_ACQUIRE, "agent");
      asm volatile("s_waitcnt vmcnt(0)" ::: "memory");
    }
  }
  __syncthreads();
}

__global__ void __launch_bounds__(256, 2) fwd_megakernel(Params p) {
  __shared__ __attribute__((aligned(16))) char smem[SMEM_BYTES];
  __shared__ uint4 xb_words;
  __shared__ int s_tile;
  char* ws = p.ws;
  if (ws == nullptr) { cg::grid_group grid = cg::this_grid(); grid.sync(); }
  if (threadIdx.x == 0) xb_words = make_uint4(0u, 0u, 0u, 0u);
  __syncthreads();
  const XcdBarrier xb = xcd_barrier_post((unsigned*)(ws + O_BAR), (volatile LAS unsigned*)&xb_words);
  const int G = gridDim.x, bid = blockIdx.x;
  const float* ADA = (const float*)(ws + O_ADA);
  float* X = (float*)(ws + O_X);

  for (int l = 0; l < NL; ++l) {
    if (l == 0) {
      for (int task = bid; task < CONV_TASKS + 384 + 2048; task += G) {
        if (task < CONV_TASKS) conv_task(p, 0, task, smem);
        else if (task < CONV_TASKS + 384) ada_task(p, task - CONV_TASKS, smem);
        else rope_task(p, task - CONV_TASKS - 384);
      }
      xcd_barrier(xb);
    }
    const float* ada_l = ADA + (size_t)l * 2 * 6144;
    const float* xin = (l == 0) ? p.in[0] : X;
    norm_rows(xin, p.in[5] + l * 1024, ada_l + 0, ada_l + 1024, (bf16_t*)(ws + O_H));
    xcd_barrier(xb);
    for (int idx = bid; idx < gemm_slots_big(39); idx += G) { int mt, nt; if (gemm_coords_big(idx, 39, mt, nt)) gemm_in_tile_big(p, l, mt, nt, smem); }
    xcd_barrier(xb);
    for (int task = bid; task < 128 + 256; task += G) {
      if (task < 128) cmp_tile(p, l, task, smem); else kmean_task(p, task - 128, smem);
    }
    xcd_barrier(xb);
    {
      unsigned* qctr = (unsigned*)(ws + O_BAR + 14336) + l * 16;
      for (;;) {
        __syncthreads();
        if (threadIdx.x == 0) s_tile = (int)atomicAdd(qctr, 1u);
        __syncthreads();
        const int rk = s_tile;
        const int nconv = (l + 1 < NL) ? CONV_TASKS : 0;
        if (rk >= 2048 + nconv) break;
        if (rk < 1024) nsa_tile(p, rk, smem);
        else if (rk < 1024 + nconv) conv_task(p, l + 1, rk - 1024, smem);
        else moba_tile(p, rk - 1024 - nconv, smem);
      }
      xcd_barrier(xb);
    }
    for (int idx = bid; idx < gemm_slots_big(8); idx += G) {
      int mt, nt;
      if (gemm_coords_big(idx, 8, mt, nt)) {
        gemm_up_pass_big((const bf16_t*)(ws + O_YA), (const bf16_t*)(ws + wdl(l) + O_WUPA), (const bf16_t*)(ws + O_GBR), 0, (bf16_t*)(ws + O_H), true, mt, nt, smem);
        gemm_up_pass_big((const bf16_t*)(ws + O_YB), (const bf16_t*)(ws + wdl(l) + O_WUPB), (const bf16_t*)(ws + O_GBR), 1024, (bf16_t*)(ws + O_H), false, mt, nt, smem);
      }
    }
    xcd_barrier(xb);
    for (int idx = bid; idx < gemm_slots_big(8); idx += G) {
      int mt, nt;
      if (gemm_coords_big(idx, 8, mt, nt)) gemm_res_tile_big((const bf16_t*)(ws + O_H), 1024, (const bf16_t*)(ws + wdl(l) + O_WOUT), 1024, xin, X, ada_l + 2048, mt, nt, smem);
    }
    xcd_barrier(xb);
    norm_rows(X, p.in[6] + l * 1024, ada_l + 3072, ada_l + 4096, (bf16_t*)(ws + O_H));
    xcd_barrier(xb);
    for (int idx = bid; idx < gemm_slots_big(44); idx += G) { int mt, nt; if (gemm_coords_big(idx, 44, mt, nt)) gemm_ffi_tile_big(p, l, mt, nt, smem); }
    xcd_barrier(xb);
    {
      float* xo = (l == NL - 1) ? p.out : X;
      for (int idx = bid; idx < gemm_slots_big(8); idx += G) {
        int mt, nt;
        if (gemm_coords_big(idx, 8, mt, nt)) gemm_res_tile_big((const bf16_t*)(ws + O_ACT), DFF, (const bf16_t*)(ws + wdl(l) + O_WFFO), DFF, X, xo, ada_l + 5120, mt, nt, smem);
      }
      if (l + 1 < NL) xcd_barrier(xb);
    }
  }
}

extern "C" void kernel_launch(void* const* d_in, const int* in_sizes, int n_in, void* d_out, int out_size,
                              void* d_ws, size_t ws_size, hipStream_t stream) {
  static int grid_blocks = 0;
  if (!grid_blocks) {
    int dev = 0, cus = 0, per_cu = 0;
    (void)hipGetDevice(&dev);
    (void)hipDeviceGetAttribute(&cus, hipDeviceAttributeMultiprocessorCount, dev);
    (void)hipOccupancyMaxActiveBlocksPerMultiprocessor(&per_cu, fwd_megakernel, 256, 0);
    if (per_cu > 2) per_cu = 2;
    if (per_cu < 1) per_cu = 1;
    grid_blocks = cus * per_cu;
    if (ws_size < WS_TOTAL) fprintf(stderr, "kernel_launch: workspace too small: %zu < %zu\n", ws_size, (size_t)WS_TOTAL);
  }
  Params p{};
  for (int i = 0; i < 22; ++i) p.in[i] = (const float*)d_in[i];
  p.out = (float*)d_out;
  p.ws = (char*)d_ws;
  (void)hipMemsetAsync((char*)d_ws + O_BAR, 0, 16384, stream);
  void* args[] = {&p};
  hipError_t e = hipLaunchCooperativeKernel((void*)fwd_megakernel, dim3(grid_blocks), dim3(256), args, 0, stream);
  if (e != hipSuccess) fprintf(stderr, "cooperative launch failed: %s (grid %d)\n", hipGetErrorString(e), grid_blocks);
}
```
